# Optimizing an MI355X kernel written in HIP

```python
import math
import jax
import jax.numpy as jnp
from jax import lax
import numpy as np

D_MODEL = 2048
BATCH = 2
SEQ = 4096
DEPTH = 4

CTX_LEN = 256
GRID_W = 64
N_EVEN = (DEPTH + 1) // 2
N_ODD = DEPTH // 2
N_MOD = 9
D_FF = 5632
EPS = 1e-6

RET_HEADS = 8
RET_DK = 128
RET_DV = 128
RET_W = RET_HEADS * RET_DK
RET_CHUNK = 64
ROPE_BASE = 10000.0
ROPE_PAIRS = (16, 24, 24)

SSD_HEADS = 16
SSD_HEADDIM = 64
SSD_INNER = SSD_HEADS * SSD_HEADDIM
SSD_GROUPS = 2
SSD_HPG = SSD_HEADS // SSD_GROUPS
SSD_STATE = 128
SSD_CONV = 3
SSD_CHUNK = 64
XBC_W = SSD_INNER + 2 * SSD_GROUPS * SSD_STATE

SC_WIDTH = 3

MIX_W = RET_W + SSD_INNER
IN_SPLITS = (RET_W, 2 * RET_W, 3 * RET_W, 4 * RET_W, 4 * RET_W + SSD_INNER, 4 * RET_W + SSD_INNER + XBC_W)
IN_W = IN_SPLITS[-1] + 2 * SSD_HEADS

kernel_name = 'hybrid_retention_ssd_shortconv_dit'


def rmsnorm(x, g):
    xf = x.astype(jnp.float32)
    y = xf * lax.rsqrt(jnp.mean(xf * xf, axis=-1, keepdims=True) + EPS)
    return (y * g.astype(jnp.float32)).astype(x.dtype)


def head_layernorm(o):
    o = o.astype(jnp.float32)
    d = o - jnp.mean(o, axis=-1, keepdims=True)
    return d * lax.rsqrt(jnp.mean(d * d, axis=-1, keepdims=True) + EPS)


def ada_mod(cond, w, b):
    m = jax.nn.silu(cond) @ w + b
    return m.reshape(cond.shape[0], N_MOD, D_MODEL)


def modulated_norm(x, g, mod, i):
    return rmsnorm(x, g) * (1.0 + mod[:, 3 * i + 1, None]) + mod[:, 3 * i, None]


def swiglu(h, w_up, w_down):
    gate, up = jnp.split(h @ w_up, 2, axis=-1)
    return (jax.nn.silu(gate) * up) @ w_down


def ffn_half(x, g, mod, i, w_up, w_down):
    return x + 0.5 * mod[:, 3 * i + 2, None] * swiglu(modulated_norm(x, g, mod, i), w_up, w_down)


def centred_dwconv(x, w):
    k = w.shape[0]
    p = k // 2
    n_pos = x.shape[1]
    xp = jnp.pad(x, ((0, 0), (p, p), (0, 0)))
    return sum(xp[:, i:i + n_pos] * w[i] for i in range(k))


def row_dwconv(x, w, rows):
    bn, n_pos, ch = x.shape
    return centred_dwconv(x.reshape(bn * rows, GRID_W, ch), w).reshape(bn, n_pos, ch)


def rotary_tables(pos):
    angs = []
    for axis, n in enumerate(ROPE_PAIRS):
        inv = ROPE_BASE ** (-jnp.arange(n, dtype=jnp.float32) / n)
        angs.append(pos[:, axis:axis + 1] * inv)
    ang = jnp.concatenate(angs, axis=-1)
    return jnp.cos(ang), jnp.sin(ang)


def apply_rotary(x, cos, sin):
    x1, x2 = jnp.split(x, 2, axis=-1)
    cos = cos[None, :, None, :].astype(x.dtype)
    sin = sin[None, :, None, :].astype(x.dtype)
    return jnp.concatenate([x1 * cos - x2 * sin, x1 * sin + x2 * cos], axis=-1)


def to_chunks(t, chunk):
    bn, n_pos = t.shape[:2]
    return jnp.moveaxis(t.reshape((bn, n_pos // chunk, chunk) + t.shape[2:]), 1, 0)


def from_chunks(t):
    t = jnp.moveaxis(t, 0, 1)
    return t.reshape((t.shape[0], t.shape[1] * t.shape[2]) + t.shape[3:])


def retention_scan(q, k, v, log_gamma, s0):
    cs = RET_CHUNK
    pos = jnp.arange(cs, dtype=jnp.float32)
    lg = log_gamma.astype(jnp.float32)
    diff = pos[:, None] - pos[None, :]
    intra = jnp.exp(jnp.where(diff >= 0, lg[:, None, None] * diff, -jnp.inf))
    q_dec = jnp.exp(lg[None, :] * (pos[:, None] + 1.0))
    k_dec = jnp.exp(lg[None, :] * (cs - 1.0 - pos[:, None]))
    c_dec = jnp.exp(lg * cs)

    def step(s, inp):
        qi, ki, vi = inp
        scores = jnp.einsum('bqhd,bkhd->bhqk', qi, ki) * intra
        o = jnp.einsum('bhqk,bkhv->bqhv', scores, vi)
        o = o + jnp.einsum('bqhd,bhdv->bqhv', qi * q_dec[:, :, None], s)
        s = s * c_dec[:, None, None] + jnp.einsum('bkhd,bkhv->bhdv', ki * k_dec[:, :, None], vi)
        return s, o

    seqs = tuple(to_chunks(t.astype(jnp.float32), cs) for t in (q, k, v))
    s, o = lax.scan(step, s0, seqs)
    return from_chunks(o), s


def ssd_scan(x, bm, cm, dt, a, s0):
    cs = SSD_CHUNK
    mask = jnp.tril(jnp.ones((cs, cs), dtype=bool))[None, :, :, None, None]

    def step(s, inp):
        xi, bi, ci, dti = inp
        cum = jnp.cumsum(dti * a, axis=1)
        seg = cum[:, :, None] - cum[:, None]
        decay = jnp.exp(jnp.where(mask, seg, -jnp.inf))
        cb = jnp.einsum('bqgn,bkgn->bqkg', ci, bi)
        w = cb[..., None] * decay * dti[:, None]
        y = jnp.einsum('bqkge,bkgep->bqgep', w, xi)
        y = y + jnp.einsum('bqgn,bgepn->bqgep', ci, s) * jnp.exp(cum)[..., None]
        to_end = jnp.exp(cum[:, -1:] - cum) * dti
        s = s * jnp.exp(cum[:, -1])[..., None, None] + jnp.einsum('bkgn,bkgep->bgepn', bi, xi * to_end[..., None])
        return s, y

    seqs = tuple(to_chunks(t.astype(jnp.float32), cs) for t in (x, bm, cm, dt))
    s, y = lax.scan(step, s0, seqs)
    return from_chunks(y), s


def bidir_scan(scan_fn, seqs_fwd, seqs_bwd, p_fwd, p_bwd, s0_fwd, s0_bwd):
    y_f, s_f = scan_fn(*seqs_fwd, p_fwd, s0_fwd)
    y_b, s_b = scan_fn(*[jnp.flip(t, 1) for t in seqs_bwd], p_bwd, s0_bwd)
    return y_f + jnp.flip(y_b, 1), s_f, s_b


def prep_branch(p, conv_fn, cos, sin, dt_bias):
    bn, n_pos, _ = p.shape
    q, k, v, g, z, xbc, dt = jnp.split(p, list(IN_SPLITS), axis=-1)
    q = apply_rotary(q.reshape(bn, n_pos, RET_HEADS, RET_DK), cos, sin)
    k = apply_rotary(k.reshape(bn, n_pos, RET_HEADS, RET_DK), cos, sin) * (RET_DK ** -0.5)
    v = v.reshape(bn, n_pos, RET_HEADS, RET_DV)
    xbc = jax.nn.silu(conv_fn(xbc))
    xs, bm, cm = jnp.split(xbc, [SSD_INNER, SSD_INNER + SSD_GROUPS * SSD_STATE], axis=-1)
    xs = xs.reshape(bn, n_pos, SSD_GROUPS, SSD_HPG, SSD_HEADDIM)
    bm = bm.reshape(bn, n_pos, SSD_GROUPS, SSD_STATE)
    cm = cm.reshape(bn, n_pos, SSD_GROUPS, SSD_STATE)
    dt = jax.nn.softplus(dt.reshape(bn, n_pos, 2, SSD_GROUPS, SSD_HPG).astype(jnp.float32)
                         + dt_bias.reshape(2, SSD_GROUPS, SSD_HPG).astype(jnp.float32))
    return (q, k, v), g, (xs, bm, cm, dt[:, :, 0], dt[:, :, 1]), z


def merge_heads(o_ret, g, y_ssd, xs, z, ssd_d, ret_gn_g, ssd_norm_g, w_out):
    bn, n_pos = g.shape[:2]
    o = head_layernorm(o_ret).reshape(bn, n_pos, RET_W) * ret_gn_g * jax.nn.silu(g)
    y = (y_ssd + ssd_d.reshape(SSD_GROUPS, SSD_HPG, 1) * xs).reshape(bn, n_pos, SSD_INNER)
    y = rmsnorm(y * jax.nn.silu(z), ssd_norm_g)
    return jnp.concatenate([o, y], axis=-1) @ w_out


def retention_ssd_mixer(hc, hl, rows, rot_c, rot_l, w_in, conv_w, conv_b, ret_log_decay, ret_gn_g,
                        ssd_a_log, ssd_dt_bias, ssd_d, ssd_norm_g, w_out, ctx_out):
    bn = hl.shape[0]
    a = -jnp.exp(ssd_a_log.astype(jnp.float32)).reshape(2, SSD_GROUPS, SSD_HPG)
    ret_c, g_c, ssd_c, z_c = prep_branch(hc @ w_in, lambda t: centred_dwconv(t, conv_w) + conv_b,
                                         rot_c[0], rot_c[1], ssd_dt_bias)
    ret_l, g_l, ssd_l, z_l = prep_branch(hl @ w_in, lambda t: row_dwconv(t, conv_w, rows) + conv_b,
                                         rot_l[0], rot_l[1], ssd_dt_bias)
    s_ret0 = jnp.zeros((bn, RET_HEADS, RET_DK, RET_DV), jnp.float32)
    s_ssd0 = jnp.zeros((bn, SSD_GROUPS, SSD_HPG, SSD_HEADDIM, SSD_STATE), jnp.float32)
    o_c, rs_f, rs_b = bidir_scan(retention_scan, ret_c, ret_c, ret_log_decay[0], ret_log_decay[1], s_ret0, s_ret0)
    y_c, ss_f, ss_b = bidir_scan(ssd_scan, (ssd_c[0], ssd_c[1], ssd_c[2], ssd_c[3]),
                                 (ssd_c[0], ssd_c[1], ssd_c[2], ssd_c[4]), a[0], a[1], s_ssd0, s_ssd0)
    o_l, _, _ = bidir_scan(retention_scan, ret_l, ret_l, ret_log_decay[0], ret_log_decay[1], rs_f, rs_b)
    y_l, _, _ = bidir_scan(ssd_scan, (ssd_l[0], ssd_l[1], ssd_l[2], ssd_l[3]),
                           (ssd_l[0], ssd_l[1], ssd_l[2], ssd_l[4]), a[0], a[1], ss_f, ss_b)
    out_l = merge_heads(o_l, g_l, y_l, ssd_l[0], z_l, ssd_d, ret_gn_g, ssd_norm_g, w_out)
    if not ctx_out:
        return None, out_l
    out_c = merge_heads(o_c, g_c, y_c, ssd_c[0], z_c, ssd_d, ret_gn_g, ssd_norm_g, w_out)
    return out_c, out_l


def short_conv_mixer(h, conv_fn, w_in, w_out):
    b_gate, c_gate, u = jnp.split(h @ w_in, 3, axis=-1)
    return (b_gate * conv_fn(c_gate * u)) @ w_out


def setup_inputs(seed: int = 0) -> dict:
    key = jax.random.key(seed)
    ks = jax.random.split(key, 24)
    f32 = jnp.float32

    def nrm(k, shape, fan_in, scale=1.0):
        return jax.random.normal(k, shape, f32) * (scale * fan_in ** -0.5)

    def gain(k, shape):
        return 1.0 + 0.05 * jax.random.normal(k, shape, f32)

    x = jax.random.normal(ks[0], (BATCH, SEQ, D_MODEL), f32)
    c = jax.random.normal(ks[1], (BATCH, D_MODEL), f32)
    ctx = jax.random.normal(ks[2], (BATCH, CTX_LEN, D_MODEL), f32)
    c_ctx = jax.random.normal(ks[3], (D_MODEL,), f32)
    ada_w = nrm(ks[4], (DEPTH, D_MODEL, N_MOD * D_MODEL), D_MODEL, 0.5)
    ada_b = 0.02 * jax.random.normal(ks[5], (DEPTH, N_MOD * D_MODEL), f32)
    norm_g = gain(ks[6], (DEPTH, 3, D_MODEL))
    final_g = gain(ks[7], (D_MODEL,))
    ffn_up = nrm(ks[8], (DEPTH, 2, D_MODEL, 2 * D_FF), D_MODEL)
    ffn_down = nrm(ks[9], (DEPTH, 2, D_FF, D_MODEL), D_FF)
    mix_w_in = nrm(ks[10], (N_EVEN, D_MODEL, IN_W), D_MODEL)
    mix_conv_w = nrm(ks[11], (N_EVEN, SSD_CONV, XBC_W), SSD_CONV)
    mix_conv_b = 0.02 * jax.random.normal(ks[12], (N_EVEN, XBC_W), f32)
    u = jax.random.uniform(ks[13], (N_EVEN, 2, RET_HEADS), f32, 0.0, 0.5)
    ret_log_decay = jnp.log1p(-jnp.exp2(-5.0 - jnp.arange(RET_HEADS, dtype=f32) - u))
    ret_gn_g = gain(ks[14], (N_EVEN, RET_W))
    ssd_a_log = jnp.log(jax.random.uniform(ks[15], (N_EVEN, 2, SSD_HEADS), f32, 1.0, 16.0))
    dt0 = jnp.exp(jax.random.uniform(ks[16], (N_EVEN, 2, SSD_HEADS), f32, math.log(1e-3), math.log(1e-1)))
    ssd_dt_bias = dt0 + jnp.log(-jnp.expm1(-dt0))
    ssd_d = gain(ks[17], (N_EVEN, SSD_HEADS))
    ssd_norm_g = gain(ks[18], (N_EVEN, SSD_INNER))
    mix_w_out = nrm(ks[19], (N_EVEN, MIX_W, D_MODEL), MIX_W)
    sc_w_in = nrm(ks[20], (N_ODD, D_MODEL, 3 * D_MODEL), D_MODEL)
    sc_conv_w = nrm(ks[21], (N_ODD, SC_WIDTH, D_MODEL), SC_WIDTH)
    sc_w_out = nrm(ks[22], (N_ODD, D_MODEL, D_MODEL), D_MODEL)
    return {'x': x, 'c': c, 'ctx': ctx, 'c_ctx': c_ctx, 'ada_w': ada_w, 'ada_b': ada_b,
            'norm_g': norm_g, 'final_g': final_g, 'ffn_up': ffn_up, 'ffn_down': ffn_down,
            'mix_w_in': mix_w_in, 'mix_conv_w': mix_conv_w, 'mix_conv_b': mix_conv_b,
            'ret_log_decay': ret_log_decay, 'ret_gn_g': ret_gn_g, 'ssd_a_log': ssd_a_log,
            'ssd_dt_bias': ssd_dt_bias, 'ssd_d': ssd_d, 'ssd_norm_g': ssd_norm_g,
            'mix_w_out': mix_w_out, 'sc_w_in': sc_w_in, 'sc_conv_w': sc_conv_w, 'sc_w_out': sc_w_out}


def reference(x, c, ctx, c_ctx, ada_w, ada_b, norm_g, final_g, ffn_up, ffn_down, mix_w_in, mix_conv_w,
              mix_conv_b, ret_log_decay, ret_gn_g, ssd_a_log, ssd_dt_bias, ssd_d, ssd_norm_g, mix_w_out,
              sc_w_in, sc_conv_w, sc_w_out):
    n_lat = x.shape[1]
    rows = n_lat // GRID_W
    n_ctx = ctx.shape[1]
    t = jnp.arange(n_lat, dtype=jnp.int32)
    pos_l = jnp.stack([jnp.full((n_lat,), n_ctx, jnp.int32), t // GRID_W, t % GRID_W], axis=-1).astype(jnp.float32)
    tc = jnp.arange(n_ctx, dtype=jnp.int32)
    pos_c = jnp.stack([tc, jnp.zeros_like(tc), jnp.zeros_like(tc)], axis=-1).astype(jnp.float32)
    rot_l = rotary_tables(pos_l)
    rot_c = rotary_tables(pos_c)

    last_even = DEPTH - 1 - (DEPTH - 1) % 2
    xl, xc = x, ctx
    hc, yc, mod_c = None, None, None
    for l in range(DEPTH):
        even = l % 2 == 0
        m = l // 2
        ctx_in = l <= last_even
        ctx_out = l < last_even
        g = norm_g[l]
        mod_l = ada_mod(c, ada_w[l], ada_b[l])
        xl = ffn_half(xl, g[0], mod_l, 0, ffn_up[l, 0], ffn_down[l, 0])
        hl = modulated_norm(xl, g[1], mod_l, 1)
        if ctx_in:
            mod_c = ada_mod(c_ctx[None], ada_w[l], ada_b[l])
            xc = ffn_half(xc, g[0], mod_c, 0, ffn_up[l, 0], ffn_down[l, 0])
            hc = modulated_norm(xc, g[1], mod_c, 1)
        if even:
            yc, yl = retention_ssd_mixer(hc, hl, rows, rot_c, rot_l, mix_w_in[m], mix_conv_w[m], mix_conv_b[m],
                                         ret_log_decay[m], ret_gn_g[m], ssd_a_log[m], ssd_dt_bias[m], ssd_d[m],
                                         ssd_norm_g[m], mix_w_out[m], ctx_out)
        else:
            conv_w = sc_conv_w[m]
            yl = short_conv_mixer(hl, lambda u: row_dwconv(u, conv_w, rows), sc_w_in[m], sc_w_out[m])
            if ctx_out:
                yc = short_conv_mixer(hc, lambda u: centred_dwconv(u, conv_w), sc_w_in[m], sc_w_out[m])
        xl = xl + mod_l[:, 5, None] * yl
        xl = ffn_half(xl, g[2], mod_l, 2, ffn_up[l, 1], ffn_down[l, 1])
        if ctx_out:
            xc = xc + mod_c[:, 5, None] * yc
            xc = ffn_half(xc, g[2], mod_c, 2, ffn_up[l, 1], ffn_down[l, 1])
    return rmsnorm(xl, final_g)
```

```cpp
#include <hip/hip_runtime.h>
#include <cstdio>
#include <cstdint>

#ifndef MK_PER_PHASE
#define MK_PER_PHASE 1
#endif
#ifndef DBG_MAXPH
#define DBG_MAXPH 99
#endif
#ifndef DBG_DUMP
#define DBG_DUMP 0
#endif

#define LAS __attribute__((address_space(3)))
#define GAS __attribute__((address_space(1)))
typedef unsigned short bf16_t;
typedef short bf16x8 __attribute__((ext_vector_type(8)));
typedef float f32x4 __attribute__((ext_vector_type(4)));
typedef float f32x2 __attribute__((ext_vector_type(2)));
typedef unsigned u32x4 __attribute__((ext_vector_type(4)));
typedef unsigned u32x2 __attribute__((ext_vector_type(2)));

constexpr int D = 2048, SEQ = 4096, CTXL = 256, MLAT = 8192, MTOT = 8704, DFF = 5632, NMODV = 18432;
constexpr int INW = 6688, XBCW = 1536;
constexpr float EPS = 1e-6f;

constexpr size_t MiB = 1u << 20;
constexpr size_t WS_CTL = 0;
constexpr size_t WS_MOD = 1 * MiB;
constexpr size_t ZERO_BYTES = 2 * MiB;
constexpr size_t WS_ROPE = 2 * MiB;
constexpr size_t WS_SSQ = 5 * MiB;
constexpr size_t WS_CHDEC = 7 * MiB;
constexpr size_t WS_DT = 8 * MiB;
constexpr size_t WS_WUP = 16 * MiB;
constexpr size_t SZ_WUP = (size_t)11264 * 2048 * 2;
constexpr size_t WS_WDN = WS_WUP + 8 * SZ_WUP;
constexpr size_t SZ_WDN = (size_t)2048 * 5632 * 2;
constexpr size_t WS_WMI = WS_WDN + 8 * SZ_WDN;
constexpr size_t SZ_WMI = (size_t)6912 * 2048 * 2;
constexpr size_t WS_WMO = WS_WMI + 2 * SZ_WMI;
constexpr size_t SZ_WSQ = (size_t)2048 * 2048 * 2;
constexpr size_t WS_WSI = WS_WMO + 2 * SZ_WSQ;
constexpr size_t SZ_WSI = (size_t)6144 * 2048 * 2;
constexpr size_t WS_WSO = WS_WSI + 2 * SZ_WSI;
constexpr size_t WS_X = WS_WSO + 2 * SZ_WSQ;
constexpr size_t WS_H = WS_X + (size_t)MTOT * D * 4;
constexpr size_t WS_HID = WS_H + (size_t)MTOT * D * 2;
constexpr size_t WS_Q = WS_HID + (size_t)MTOT * DFF * 2;
constexpr size_t SZ_P1 = (size_t)MTOT * 1024 * 2;
constexpr size_t WS_K = WS_Q + SZ_P1, WS_V = WS_K + SZ_P1, WS_G = WS_V + SZ_P1, WS_Z = WS_G + SZ_P1;
constexpr size_t WS_XBC = WS_Z + SZ_P1;
constexpr size_t WS_BG = WS_Q;
constexpr size_t WS_T = WS_Q + (size_t)MTOT * D * 2;
constexpr size_t WS_MRG = WS_XBC + (size_t)MTOT * XBCW * 2;
constexpr size_t WS_RST = WS_MRG + (size_t)MTOT * D * 2;
constexpr size_t SZ_ST = (size_t)68 * 524288 * 2;
constexpr size_t WS_SST = WS_RST + SZ_ST;
constexpr size_t WS_PART = WS_SST + SZ_ST;
constexpr size_t WS_END = WS_PART + (size_t)16 * 12 * NMODV * 4;
static_assert(WS_T + (size_t)MTOT * D * 2 <= WS_MRG, "odd-layer overlay fits");
static_assert(WS_XBC == WS_Q + 5 * SZ_P1, "EpiInEven addresses Q|K|V|G|Z|XBC from one base");
static_assert(WS_WUP % 256 == 0 && WS_X % 256 == 0 && WS_Q % 256 == 0 && WS_RST % 256 == 0, "alignment");

constexpr int LDS_BYTES = 147456;
constexpr int LDS_MISC = 143360;

typedef __bf16 bf16x2_t __attribute__((ext_vector_type(2)));
__device__ __forceinline__ unsigned cvt_pk_bf16(float lo, float hi) { const f32x2 v = {lo, hi}; const bf16x2_t b = __builtin_convertvector(v, bf16x2_t); return __builtin_bit_cast(unsigned, b); }
__device__ __forceinline__ bf16_t f2bf(float f) { return (bf16_t)(cvt_pk_bf16(f, 0.f) & 0xffffu); }
__device__ __forceinline__ float bf2f(bf16_t v) { return __uint_as_float((unsigned)v << 16); }
__device__ __forceinline__ void unpack8(const u32x4 v, float* f) {
    f[0] = __uint_as_float(v.x << 16); f[1] = __uint_as_float(v.x & 0xffff0000u); f[2] = __uint_as_float(v.y << 16); f[3] = __uint_as_float(v.y & 0xffff0000u);
    f[4] = __uint_as_float(v.z << 16); f[5] = __uint_as_float(v.z & 0xffff0000u); f[6] = __uint_as_float(v.w << 16); f[7] = __uint_as_float(v.w & 0xffff0000u); }
__device__ __forceinline__ u32x4 pack8(const float* f) { u32x4 w; w.x = cvt_pk_bf16(f[0], f[1]); w.y = cvt_pk_bf16(f[2], f[3]); w.z = cvt_pk_bf16(f[4], f[5]); w.w = cvt_pk_bf16(f[6], f[7]); return w; }
__device__ __forceinline__ float silu_f(float x) { return x * __builtin_amdgcn_rcpf(1.0f + __builtin_amdgcn_exp2f(-1.4426950408889634f * x)); }
__device__ __forceinline__ float fexp(float x) { return __builtin_amdgcn_exp2f(1.4426950408889634f * x); }

namespace pg8 {
constexpr int BM = 256, BK = 64, HALF = 128, HTB = HALF * BK * 2, STAGE_BYTES = 8 * HTB, NXCD = 8, WGM = 8;
__host__ __device__ __forceinline__ int lds_byte(int r, int c) { const int st = (r >> 4) * 2 + (c >> 5), rr = r & 15, cc = c & 31, ob = rr * 64 + cc * 2; return st * 1024 + (ob ^ (((ob >> 9) & 1) << 5)); }
__host__ __device__ __forceinline__ void stage_rc(int b, int& R, int& C) { const int st = b / 1024, sb = b % 1024, swz = sb ^ (((sb >> 9) & 1) << 5); R = (st >> 1) * 16 + swz / 64; C = (st & 1) * 32 + (swz % 64) / 2; }
__host__ __device__ __forceinline__ int perm32(int rho) { const int n = rho >> 4, i = rho & 15; return 8 * (i >> 2) + 4 * n + (i & 3); }
struct Unit { int pm, pn; };
struct Gemm { const bf16_t* A; const bf16_t* Bt; int K; };
struct StaticOrder {
    int nM, nN, nwg, G, c;
    __host__ __device__ void init(int M, int N, int G_, int c_) { nM = M / BM; nN = N / BM; nwg = nM * nN; G = G_; c = c_; }
    __host__ __device__ bool next(int i, Unit& u) const {
        const long L = (long)i * G + c; if (L >= nwg) return false;
        int wgid = (int)L; { const int q = nwg / NXCD, r = nwg % NXCD, xcd = wgid % NXCD, off = wgid / NXCD; wgid = (xcd < r ? xcd * (q + 1) : r * (q + 1) + (xcd - r) * q) + off; }
        const int nig = WGM * nN, gid = wgid / nig, fm = gid * WGM, gsz = (nM - fm) < WGM ? (nM - fm) : WGM;
        u.pm = fm + ((wgid % nig) % gsz); u.pn = (wgid % nig) / gsz; return true;
    }
    __device__ __forceinline__ void a_ready(const Unit&) const {}
    __device__ __forceinline__ void done(const Unit&) const {}
};
template <class Epi, class Sched, bool ALIGN_EPI = false, bool SP2 = false>
__device__ __forceinline__ void gemm_phase(LAS unsigned char* lds, const int tid, const Gemm g, const Sched& S, const Epi& E) {
    const int wid = __builtin_amdgcn_readfirstlane(tid >> 6), lane = tid & 63, wr = wid >> 2, wc = wid & 3, fr = lane & 15, fq = lane >> 4;
    const int K = g.K, nt = K / BK;
    unsigned voffA[2], voffB[2];
#pragma unroll
    for (int i = 0; i < 2; ++i) { int R, C; stage_rc(tid * 16 + i * 8192, R, C); const int Rb = Epi::PERM ? ((R & ~31) + perm32(R & 31)) : R;
        voffA[i] = (unsigned)(R * K + C) * 2u; voffB[i] = (unsigned)(Rb * K + C) * 2u; }
    const size_t kstep = (size_t)(BK * 2);
    const size_t hstep = (size_t)HALF * K * 2;
    const size_t tstep = 2 * hstep;
    const unsigned ldsw = (unsigned)wid * 1024u;
    const int aoff = lds_byte(wr * 64 + fr, fq * 8), boff = lds_byte(wc * 32 + fr, fq * 8);
#define PG8_SA(b, h) (((b) * 2 + (h)) * HTB)
#define PG8_SB(b, h) ((4 + (b) * 2 + (h)) * HTB)
#define PG8_STAGE(bufoff, gbase, voff) do { _Pragma("unroll") for (int _i = 0; _i < 2; ++_i) \
        __builtin_amdgcn_global_load_lds((const unsigned*)((const char*)(gbase) + (voff)[_i]), (LAS unsigned*)(lds + (bufoff) + ldsw + _i * 8192), 16, 0, 0); } while (0)
#define PG8_LDA(dst, b, h) do { _Pragma("unroll") for (int m = 0; m < 4; ++m) _Pragma("unroll") for (int k = 0; k < 2; ++k) dst[m][k] = *(const LAS bf16x8*)(lds + PG8_SA(b, h) + aoff + m * 2048 + k * 1024); } while (0)
#define PG8_LDB(dst, b, h) do { _Pragma("unroll") for (int n = 0; n < 2; ++n) _Pragma("unroll") for (int k = 0; k < 2; ++k) dst[n][k] = *(const LAS bf16x8*)(lds + PG8_SB(b, h) + boff + n * 2048 + k * 1024); } while (0)
#define PG8_MMA(ai, bj, At, Bt) do { __builtin_amdgcn_s_setprio(1); _Pragma("unroll") for (int m = 0; m < 4; ++m) _Pragma("unroll") for (int n = 0; n < 2; ++n) _Pragma("unroll") for (int k = 0; k < 2; ++k) \
        acc[ai][bj][m][n] = __builtin_amdgcn_mfma_f32_16x16x32_bf16(Bt[n][k], At[m][k], acc[ai][bj][m][n], 0, 0, 0); __builtin_amdgcn_s_setprio(0); } while (0)
#define PG8_WAIT_V(n) asm volatile("s_waitcnt vmcnt(" #n ")" ::: "memory")
#define PG8_WAIT_L(n) asm volatile("s_waitcnt lgkmcnt(" #n ")" ::: "memory")
#define PG8_BAR __builtin_amdgcn_s_barrier()
#define PG8_SCHED __builtin_amdgcn_sched_barrier(0)
    Unit cur, nxt; int ui = 0;
    if (!S.next(0, cur)) return;
    f32x4 acc[2][2][4][2];
#pragma unroll
    for (int a = 0; a < 2; ++a)
#pragma unroll
        for (int b = 0; b < 2; ++b)
#pragma unroll
            for (int m = 0; m < 4; ++m)
#pragma unroll
                for (int n = 0; n < 2; ++n) acc[a][b][m][n] = (f32x4){0.f, 0.f, 0.f, 0.f};
    bf16x8 At[4][2], B0[2][2], B1[2][2];
    const char* cA = (const char*)g.A + (size_t)cur.pm * tstep; const char* cB = (const char*)g.Bt + (size_t)cur.pn * tstep;
    S.a_ready(cur);
    if constexpr (SP2) {
        PG8_STAGE(PG8_SB(0, 0), cB, voffB); PG8_STAGE(PG8_SB(0, 1), cB + hstep, voffB); PG8_STAGE(PG8_SA(0, 0), cA, voffA); PG8_STAGE(PG8_SA(0, 1), cA + hstep, voffA);
        if (wr == 1) PG8_BAR;
        PG8_WAIT_V(2); PG8_BAR;
        PG8_STAGE(PG8_SB(1, 0), cB + kstep, voffB); PG8_STAGE(PG8_SA(1, 0), cA + kstep, voffA); PG8_STAGE(PG8_SB(1, 1), cB + hstep + kstep, voffB);
        PG8_WAIT_V(6); PG8_BAR;
    } else {
        PG8_STAGE(PG8_SB(0, 0), cB, voffB); PG8_STAGE(PG8_SA(0, 0), cA, voffA); PG8_STAGE(PG8_SB(0, 1), cB + hstep, voffB); PG8_STAGE(PG8_SA(0, 1), cA + hstep, voffA);
        if (wr == 1) PG8_BAR;
        PG8_WAIT_V(4); PG8_BAR;
        PG8_STAGE(PG8_SB(1, 0), cB + kstep, voffB); PG8_STAGE(PG8_SA(1, 0), cA + kstep, voffA); PG8_STAGE(PG8_SB(1, 1), cB + hstep + kstep, voffB);
        PG8_WAIT_V(6); PG8_BAR;
    }
    for (;;) {
        const bool has_next = S.next(ui + 1, nxt);
        const char* nA = has_next ? (const char*)g.A + (size_t)nxt.pm * tstep : cA; const char* nB = has_next ? (const char*)g.Bt + (size_t)nxt.pn * tstep : cB;
        for (int t = 0; t < nt; t += 2) {
            const bool last = (t == nt - 2);
            const char* a1 = cA + (size_t)(t + 1) * kstep;
            const char* a2 = last ? nA : cA + (size_t)(t + 2) * kstep; const char* b2 = last ? nB : cB + (size_t)(t + 2) * kstep;
            const char* a3 = a2 + kstep; const char* b3 = b2 + kstep;
            if (last && has_next) S.a_ready(nxt);
            if constexpr (SP2) {
            PG8_LDB(B0, 0, 0); PG8_LDB(B1, 0, 1); PG8_SCHED; PG8_LDA(At, 0, 0); PG8_STAGE(PG8_SA(1, 1), a1 + hstep, voffA);
            PG8_WAIT_V(8); PG8_WAIT_L(0); PG8_BAR; PG8_MMA(0, 0, At, B0); PG8_MMA(0, 1, At, B1); PG8_BAR; PG8_SCHED;
            PG8_LDA(At, 0, 1); PG8_STAGE(PG8_SB(0, 0), b2, voffB); PG8_STAGE(PG8_SB(0, 1), b2 + hstep, voffB); PG8_STAGE(PG8_SA(0, 0), a2, voffA);
            PG8_WAIT_V(8); PG8_WAIT_L(0); PG8_BAR; PG8_MMA(1, 0, At, B0); PG8_MMA(1, 1, At, B1); PG8_BAR; PG8_SCHED;
            PG8_LDB(B0, 1, 0); PG8_LDB(B1, 1, 1); PG8_SCHED; PG8_LDA(At, 1, 0); PG8_STAGE(PG8_SA(0, 1), a2 + hstep, voffA);
            PG8_WAIT_V(8); PG8_WAIT_L(0); PG8_BAR; PG8_MMA(0, 0, At, B0); PG8_MMA(0, 1, At, B1); PG8_BAR; PG8_SCHED;
            PG8_LDA(At, 1, 1); PG8_STAGE(PG8_SB(1, 0), b3, voffB); PG8_STAGE(PG8_SB(1, 1), b3 + hstep, voffB); PG8_STAGE(PG8_SA(1, 0), a3, voffA);
            PG8_WAIT_V(8); PG8_WAIT_L(0); PG8_BAR; PG8_MMA(1, 0, At, B0); PG8_MMA(1, 1, At, B1); PG8_BAR; PG8_SCHED;
            } else {
            PG8_LDB(B0, 0, 0); PG8_SCHED; PG8_LDA(At, 0, 0); PG8_STAGE(PG8_SA(1, 1), a1 + hstep, voffA);
            PG8_WAIT_L(8); PG8_BAR; PG8_WAIT_L(0); PG8_MMA(0, 0, At, B0); PG8_BAR; PG8_SCHED;
            PG8_LDB(B1, 0, 1); PG8_STAGE(PG8_SB(0, 0), b2, voffB);
            PG8_BAR; PG8_WAIT_L(0); PG8_MMA(0, 1, At, B1); PG8_BAR;
            PG8_LDA(At, 0, 1); PG8_STAGE(PG8_SA(0, 0), a2, voffA);
            PG8_BAR; PG8_WAIT_L(0); PG8_MMA(1, 0, At, B0); PG8_BAR; PG8_SCHED;
            PG8_STAGE(PG8_SB(0, 1), b2 + hstep, voffB);
            PG8_WAIT_V(6); PG8_BAR; PG8_MMA(1, 1, At, B1); PG8_BAR;
            PG8_LDB(B0, 1, 0); PG8_SCHED; PG8_LDA(At, 1, 0); PG8_STAGE(PG8_SA(0, 1), a2 + hstep, voffA);
            PG8_WAIT_L(8); PG8_BAR; PG8_WAIT_L(0); PG8_MMA(0, 0, At, B0); PG8_BAR; PG8_SCHED;
            PG8_LDB(B1, 1, 1); PG8_STAGE(PG8_SB(1, 0), b3, voffB);
            PG8_BAR; PG8_WAIT_L(0); PG8_MMA(0, 1, At, B1); PG8_BAR;
            PG8_LDA(At, 1, 1); PG8_STAGE(PG8_SA(1, 0), a3, voffA);
            PG8_BAR; PG8_WAIT_L(0); PG8_MMA(1, 0, At, B0); PG8_BAR; PG8_SCHED;
            PG8_STAGE(PG8_SB(1, 1), b3 + hstep, voffB);
            PG8_WAIT_V(6); PG8_BAR; PG8_MMA(1, 1, At, B1); PG8_BAR;
            }
        }
        if constexpr (ALIGN_EPI) { if (wr == 0) PG8_BAR; }
        E(acc, cur, wr, wc, fr, fq); S.done(cur);
        if (!has_next) break;
#pragma unroll
        for (int a = 0; a < 2; ++a)
#pragma unroll
            for (int b = 0; b < 2; ++b)
#pragma unroll
                for (int m = 0; m < 4; ++m)
#pragma unroll
                    for (int n = 0; n < 2; ++n) acc[a][b][m][n] = (f32x4){0.f, 0.f, 0.f, 0.f};
        cur = nxt; cA = nA; cB = nB; ++ui;
        if constexpr (ALIGN_EPI) { if (wr == 1) PG8_BAR; }
    }
    PG8_WAIT_V(0);
    if constexpr (!ALIGN_EPI) { if (wr == 0) PG8_BAR; }
    PG8_BAR;
#undef PG8_SA
#undef PG8_SB
#undef PG8_STAGE
#undef PG8_LDA
#undef PG8_LDB
#undef PG8_MMA
#undef PG8_WAIT_V
#undef PG8_WAIT_L
#undef PG8_BAR
#undef PG8_SCHED
}

struct EpiUp { static constexpr bool PERM = true; bf16_t* O;
    __device__ __forceinline__ void operator()(const f32x4 (&acc)[2][2][4][2], const Unit& u, int wr, int wc, int fr, int fq) const {
        const int row0 = u.pm * BM + wr * 64 + fr, col0 = u.pn * 128 + wc * 32 + 8 * fq;
#pragma unroll
        for (int ai = 0; ai < 2; ++ai)
#pragma unroll
            for (int m = 0; m < 4; ++m) { bf16_t* rowp = O + (size_t)(row0 + ai * HALF + m * 16) * DFF + col0;
                const f32x4 g0 = acc[ai][0][m][0], g1 = acc[ai][0][m][1], u0 = acc[ai][1][m][0], u1 = acc[ai][1][m][1];
                u32x4 w; w.x = cvt_pk_bf16(silu_f(g0[0]) * u0[0], silu_f(g0[1]) * u0[1]); w.y = cvt_pk_bf16(silu_f(g0[2]) * u0[2], silu_f(g0[3]) * u0[3]);
                w.z = cvt_pk_bf16(silu_f(g1[0]) * u1[0], silu_f(g1[1]) * u1[1]); w.w = cvt_pk_bf16(silu_f(g1[2]) * u1[2], silu_f(g1[3]) * u1[3]);
                *(u32x4*)rowp = w; }
    }
};
struct EpiRes { static constexpr bool PERM = false; float* X; const float* gate; float gs;
    __device__ __forceinline__ void operator()(const f32x4 (&acc)[2][2][4][2], const Unit& u, int wr, int wc, int fr, int fq) const {
        const int row0 = u.pm * BM + wr * 64 + fr, col0 = u.pn * BM + wc * 32 + 4 * fq;
        const int b = u.pm < 16 ? 0 : (u.pm < 32 ? 1 : 2);
        f32x4 gv[2][2];
#pragma unroll
        for (int bj = 0; bj < 2; ++bj)
#pragma unroll
            for (int n = 0; n < 2; ++n) gv[bj][n] = *(const f32x4*)(gate + (size_t)b * NMODV + col0 + bj * HALF + n * 16) * gs;
#pragma unroll
        for (int ai = 0; ai < 2; ++ai)
#pragma unroll
            for (int m = 0; m < 4; ++m) { float* rowp = X + (size_t)(row0 + ai * HALF + m * 16) * D + col0;
#pragma unroll
                for (int bj = 0; bj < 2; ++bj)
#pragma unroll
                    for (int n = 0; n < 2; ++n) { f32x4* p = (f32x4*)(rowp + bj * HALF + n * 16); *p = *p + gv[bj][n] * acc[ai][bj][m][n]; } }
    }
};
__device__ __forceinline__ void store8(bf16_t* p, const f32x4 a, const f32x4 b) { u32x4 w; w.x = cvt_pk_bf16(a[0], a[1]); w.y = cvt_pk_bf16(a[2], a[3]); w.z = cvt_pk_bf16(b[0], b[1]); w.w = cvt_pk_bf16(b[2], b[3]); *(u32x4*)p = w; }
struct EpiInEven { static constexpr bool PERM = true; bf16_t* P0; float* DT; const float* cosT; const float* sinT; const float* dtb;
    __device__ __forceinline__ void operator()(const f32x4 (&acc)[2][2][4][2], const Unit& u, int wr, int wc, int fr, int fq) const {
        const int pn = u.pn, row0 = u.pm * BM + wr * 64 + fr;
        const int ti = pn < 20 ? (pn >> 2) : 5; bf16_t* base = P0 + (size_t)ti * ((size_t)MTOT * 1024);
        if (pn < 8) {
            const float sc = pn < 4 ? 1.0f : 0.08838834764831845f;
            const int cb = (pn & 3) * 256 + wc * 32 + 8 * fq, jp = 16 * wc + 4 * fq;
#pragma unroll
            for (int ai = 0; ai < 2; ++ai)
#pragma unroll
                for (int m = 0; m < 4; ++m) { const int row = row0 + ai * HALF + m * 16; const int tr = row < MLAT ? (row & 4095) : 4096 + ((row - MLAT) & 255);
                    const f32x4 cs = *(const f32x4*)(cosT + tr * 64 + jp) * sc, sn = *(const f32x4*)(sinT + tr * 64 + jp) * sc;
#pragma unroll
                    for (int bj = 0; bj < 2; ++bj) { const f32x4 x1 = acc[ai][bj][m][0], x2 = acc[ai][bj][m][1];
                        store8(base + (size_t)row * 1024 + cb + bj * HALF, x1 * cs - x2 * sn, x1 * sn + x2 * cs); } }
        } else if (pn < 26) {
            const int pitch = pn < 20 ? 1024 : XBCW; const int c0 = (pn < 20 ? (pn & 3) : (pn - 20)) * 256 + wc * 32 + 8 * fq;
#pragma unroll
            for (int ai = 0; ai < 2; ++ai)
#pragma unroll
                for (int m = 0; m < 4; ++m) { bf16_t* rowp = base + (size_t)(row0 + ai * HALF + m * 16) * pitch + c0;
#pragma unroll
                    for (int bj = 0; bj < 2; ++bj) store8(rowp + bj * HALF, acc[ai][bj][m][0], acc[ai][bj][m][1]); }
        } else if (wc == 0) {
#pragma unroll
            for (int ai = 0; ai < 2; ++ai)
#pragma unroll
                for (int m = 0; m < 4; ++m) { const int row = row0 + ai * HALF + m * 16;
#pragma unroll
                    for (int n = 0; n < 2; ++n) { const int col = 8 * fq + 4 * n; f32x4 v = acc[ai][0][m][n] + *(const f32x4*)(dtb + col);
#pragma unroll
                        for (int j = 0; j < 4; ++j) v[j] = v[j] > 20.f ? v[j] : log1pf(expf(v[j]));
                        *(f32x4*)(DT + (size_t)row * 32 + col) = v; } }
        }
    }
};
struct EpiInOdd { static constexpr bool PERM = true; bf16_t *BG, *T;
    __device__ __forceinline__ void operator()(const f32x4 (&acc)[2][2][4][2], const Unit& u, int wr, int wc, int fr, int fq) const {
        const int pn = u.pn, row0 = u.pm * BM + wr * 64 + fr;
        if (pn < 8) { const int c0 = pn * 256 + wc * 32 + 8 * fq;
#pragma unroll
            for (int ai = 0; ai < 2; ++ai)
#pragma unroll
                for (int m = 0; m < 4; ++m) { bf16_t* rowp = BG + (size_t)(row0 + ai * HALF + m * 16) * D + c0;
#pragma unroll
                    for (int bj = 0; bj < 2; ++bj) store8(rowp + bj * HALF, acc[ai][bj][m][0], acc[ai][bj][m][1]); }
        } else { const int c0 = (pn - 8) * 128 + wc * 32 + 8 * fq;
#pragma unroll
            for (int ai = 0; ai < 2; ++ai)
#pragma unroll
                for (int m = 0; m < 4; ++m) store8(T + (size_t)(row0 + ai * HALF + m * 16) * D + c0, acc[ai][0][m][0] * acc[ai][1][m][0], acc[ai][0][m][1] * acc[ai][1][m][1]);
        }
    }
};
}

#define XB_TMO      128
#define XB_XCNT(j)  (256  + 64 * (j))
#define XB_XSUB(j)  (1280 + 64 * (j))
#define XB_XGEN(j)  (2304 + 64 * (j))
#define XB_TOP      3328
#define XB_TOPGEN   3392
#define XCD_BAR_WORDS 3456
#define XB_SPIN_CAP (1u << 18)
__device__ __forceinline__ unsigned xb_ld(unsigned* p)              { return __hip_atomic_load(p, __ATOMIC_RELAXED, __HIP_MEMORY_SCOPE_AGENT); }
__device__ __forceinline__ unsigned xb_add(unsigned* p, unsigned v) { return __hip_atomic_fetch_add(p, v, __ATOMIC_RELAXED, __HIP_MEMORY_SCOPE_AGENT); }
__device__ __forceinline__ unsigned xb_xcc_id() { return (unsigned)__builtin_amdgcn_s_getreg((3 << 11) | 20) & 0xFu; }
#define XB_SPIN(cond, bar) do { unsigned _sp = 0; while (cond) { __builtin_amdgcn_s_sleep(1); \
    if ((++_sp & 255u) == 0u) { if (xb_ld(&(bar)[XB_TMO])) break; if (_sp > XB_SPIN_CAP) { atomicAdd(&(bar)[XB_TMO], 1u); break; } } } } while (0)
struct XcdBarrier { unsigned* bar; unsigned x; volatile LAS unsigned* st; };
__device__ __forceinline__ XcdBarrier xcd_barrier_post(unsigned* bar, volatile LAS unsigned* st) {
    XcdBarrier b; b.bar = bar; b.x = xb_xcc_id(); b.st = st;
    if (threadIdx.x == 0) (void)xb_add(&bar[XB_XCNT(b.x)], 1u);
    return b;
}
__device__ __forceinline__ void xcd_barrier_complete(unsigned* bar, unsigned x, unsigned& nloc, unsigned& nx) {
    const unsigned G = gridDim.x * gridDim.y * gridDim.z;
    unsigned sum, cnt, mine, sp = 0u;
    for (;;) {
        sum = 0u; cnt = 0u; mine = 0u;
#pragma unroll
        for (unsigned j = 0; j < 16; ++j) { const unsigned c = xb_ld(&bar[XB_XCNT(j)]); sum += c; cnt += (c > 0u) ? 1u : 0u; mine = (j == x) ? c : mine; }
        if (sum == G) break;
        __builtin_amdgcn_s_sleep(1);
        if ((++sp & 255u) == 0u) { if (xb_ld(&bar[XB_TMO])) break; if (sp > XB_SPIN_CAP) { atomicAdd(&bar[XB_TMO], 1u); break; } }
    }
    nloc = mine > 0u ? mine : 1u; nx = cnt > 0u ? cnt : 1u;
}
__device__ __forceinline__ void xcd_barrier(const XcdBarrier& b) {
    asm volatile("s_waitcnt vmcnt(0)" ::: "memory");
    __syncthreads();
    if (threadIdx.x == 0) {
        unsigned* bar = b.bar;
        __builtin_amdgcn_s_waitcnt(0);
        unsigned nloc = b.st[0], nx = b.st[1];
        if (nloc == 0u) { xcd_barrier_complete(bar, b.x, nloc, nx); b.st[0] = nloc; b.st[1] = nx; }
        const unsigned old = xb_add(&bar[XB_XSUB(b.x)], 1u);
        const unsigned gen = old / nloc;
        if (old + 1u == (gen + 1u) * nloc) {
            __builtin_amdgcn_fence(__ATOMIC_RELEASE, "agent");
            asm volatile("s_waitcnt vmcnt(0)" ::: "memory");
            const unsigned og = xb_add(&bar[XB_TOP], 1u);
            const unsigned tg = og / nx;
            if (og + 1u == (tg + 1u) * nx) xb_add(&bar[XB_TOPGEN], 1u);
            else XB_SPIN(xb_ld(&bar[XB_TOPGEN]) == tg, bar);
            __builtin_amdgcn_fence(__ATOMIC_ACQUIRE, "agent");
            xb_add(&bar[XB_XGEN(b.x)], 1u);
            asm volatile("s_waitcnt vmcnt(0)" ::: "memory");
        } else {
            XB_SPIN(xb_ld(&bar[XB_XGEN(b.x)]) == gen, bar);
            __builtin_amdgcn_fence(__ATOMIC_ACQUIRE, "agent");
            asm volatile("s_waitcnt vmcnt(0)" ::: "memory");
        }
    }
    __syncthreads();
}

struct Args { const float* in[23]; float* out; unsigned char* ws; int ph_lo, ph_hi; };
enum { I_X = 0, I_C, I_CTX, I_CCTX, I_ADAW, I_ADAB, I_NORMG, I_FINALG, I_FUP, I_FDN, I_MWIN, I_MCW, I_MCB, I_RLD, I_RGN, I_SALOG, I_SDTB, I_SD, I_SNG, I_MWOUT, I_SCWIN, I_SCCW, I_SCWOUT };
struct Frame { LAS unsigned char* lds; unsigned char* ws; int tid, lane, wave, vcu, G; };
#define LDS_WAIT() asm volatile("s_waitcnt lgkmcnt(0)" ::: "memory")
__device__ __forceinline__ Frame mk_frame(unsigned char* ws_in, LAS unsigned char* lds_in, int G, int vcu) {
    Frame F; int t = threadIdx.x; asm volatile("" : "+v"(t)); F.tid = t; F.lane = t & 63; F.wave = __builtin_amdgcn_readfirstlane(t >> 6);
    unsigned long long w = (unsigned long long)ws_in; asm volatile("" : "+s"(w)); F.ws = (unsigned char*)w;
    unsigned lb = 0; asm volatile("" : "+s"(lb)); F.lds = lds_in + lb; F.G = G; F.vcu = vcu; return F; }

__device__ __forceinline__ float wave_sum(float v) {
#pragma unroll
    for (int o = 1; o < 64; o <<= 1) v += __shfl_xor(v, o);
    return v;
}

__device__ __forceinline__ int dest_row(int mode, int n) {
    if (mode == 1) { const int half = n >= DFF ? 1 : 0, j = n - half * DFF; return 256 * (j >> 7) + 128 * half + (j & 127); }
    if (mode == 2) { if (n >= 2048) return n; const int hd = n >> 7, j = n & 127, hb = j >> 6, jj = j & 63; return hd * 128 + 32 * (jj >> 4) + 8 * ((jj >> 2) & 3) + 4 * hb + (jj & 3); }
    if (mode == 3) { if (n < 2048) return n; if (n < 4096) { const int j = n - 2048; return 2048 + 256 * (j >> 7) + (j & 127); } const int j = n - 4096; return 2048 + 256 * (j >> 7) + 128 + (j & 127); }
    return n;
}
__device__ __forceinline__ void xpose_item(const float* W, int K, int N, bf16_t* WT, int mode, LAS float* scr, int item, int lane) {
    const int nnb = (N + 63) >> 6, kb = item / nnb, nb = item - kb * nnb, k0 = 64 * kb, n0 = 64 * nb;
    const int c4 = (lane & 15) * 4; const bool cok = (n0 + c4) < N;
    f32x4 v[16];
#pragma unroll
    for (int i = 0; i < 16; ++i) { const int kk = 4 * i + (lane >> 4); v[i] = cok ? *(const f32x4*)(W + (size_t)(k0 + kk) * N + n0 + c4) : (f32x4){0.f, 0.f, 0.f, 0.f}; }
#pragma unroll
    for (int i = 0; i < 16; ++i) { const int kk = 4 * i + (lane >> 4); LAS float* s = scr + kk * 65 + c4; s[0] = v[i][0]; s[1] = v[i][1]; s[2] = v[i][2]; s[3] = v[i][3]; }
    LDS_WAIT(); asm volatile("" ::: "memory");
    const int nl = lane >> 3, c = lane & 7;
#pragma unroll
    for (int j = 0; j < 8; ++j) { const int n = 8 * j + nl; const LAS float* s = scr + (8 * c) * 65 + n;
        u32x4 o; o.x = cvt_pk_bf16(s[0], s[65]); o.y = cvt_pk_bf16(s[2 * 65], s[3 * 65]); o.z = cvt_pk_bf16(s[4 * 65], s[5 * 65]); o.w = cvt_pk_bf16(s[6 * 65], s[7 * 65]);
        if (n0 + n < N) *(u32x4*)(WT + (size_t)dest_row(mode, n0 + n) * K + k0 + 8 * c) = o; }
    LDS_WAIT(); asm volatile("" ::: "memory");
}
__device__ __forceinline__ void prologue(const Frame& F, const Args& a) {
    LAS float* scr = (LAS float*)(F.lds + F.wave * 16640);
    const int gw = F.vcu * 8 + F.wave, NGW = F.G * 8, lane = F.lane;
    unsigned char* ws = F.ws;
    for (int it = gw; it < 4 * 16 * 72; it += NGW) {
        const int l = it / (16 * 72), r = it - l * (16 * 72), ks = r / 72, cg = r - ks * 72, k0 = ks * 128, n0 = cg * 256 + 4 * lane;
        LAS float* sl = scr;
#pragma unroll
        for (int w = 0; w < 3; ++w)
#pragma unroll
            for (int hh = 0; hh < 2; ++hh) { const int k = k0 + hh * 64 + lane; const float cv = w < 2 ? a.in[I_C][w * D + k] : a.in[I_CCTX][k]; sl[w * 128 + hh * 64 + lane] = cv / (1.0f + expf(-cv)); }
        LDS_WAIT(); asm volatile("" ::: "memory");
        const float* Wp = a.in[I_ADAW] + ((size_t)l * D + k0) * NMODV + n0;
        f32x4 a0 = {0.f, 0.f, 0.f, 0.f}, a1 = a0, a2 = a0;
#pragma unroll 8
        for (int kk = 0; kk < 128; ++kk) { const f32x4 w = *(const f32x4*)(Wp + (size_t)kk * NMODV); a0 += w * sl[kk]; a1 += w * sl[128 + kk]; a2 += w * sl[256 + kk]; }
        float* po = (float*)(ws + WS_PART) + ((size_t)(ks * 4 + l) * 3) * NMODV + n0;
        *(f32x4*)po = a0; *(f32x4*)(po + NMODV) = a1; *(f32x4*)(po + 2 * NMODV) = a2;
        LDS_WAIT(); asm volatile("" ::: "memory");
    }
    constexpr int I_UP = 32 * 176, I_DN = 88 * 32, I_MI = 32 * 105, I_SQ = 32 * 32, I_SI = 32 * 96;
    constexpr int B0 = 8 * I_UP, B1 = B0 + 8 * I_DN, B2 = B1 + 2 * I_MI, B3 = B2 + 2 * I_SQ, B4 = B3 + 2 * I_SI, B5 = B4 + 2 * I_SQ;
    for (int it = gw; it < B5; it += NGW) {
        if (it < B0) { const int mi = it / I_UP; xpose_item(a.in[I_FUP] + (size_t)mi * D * 2 * DFF, D, 2 * DFF, (bf16_t*)(ws + WS_WUP + mi * SZ_WUP), 1, scr, it - mi * I_UP, lane); }
        else if (it < B1) { const int r = it - B0, mi = r / I_DN; xpose_item(a.in[I_FDN] + (size_t)mi * DFF * D, DFF, D, (bf16_t*)(ws + WS_WDN + mi * SZ_WDN), 0, scr, r - mi * I_DN, lane); }
        else if (it < B2) { const int r = it - B1, mi = r / I_MI; xpose_item(a.in[I_MWIN] + (size_t)mi * D * INW, D, INW, (bf16_t*)(ws + WS_WMI + mi * SZ_WMI), 2, scr, r - mi * I_MI, lane); }
        else if (it < B3) { const int r = it - B2, mi = r / I_SQ; xpose_item(a.in[I_MWOUT] + (size_t)mi * D * D, D, D, (bf16_t*)(ws + WS_WMO + mi * SZ_WSQ), 0, scr, r - mi * I_SQ, lane); }
        else if (it < B4) { const int r = it - B3, mi = r / I_SI; xpose_item(a.in[I_SCWIN] + (size_t)mi * D * 3 * D, D, 3 * D, (bf16_t*)(ws + WS_WSI + mi * SZ_WSI), 3, scr, r - mi * I_SI, lane); }
        else { const int r = it - B4, mi = r / I_SQ; xpose_item(a.in[I_SCWOUT] + (size_t)mi * D * D, D, D, (bf16_t*)(ws + WS_WSO + mi * SZ_WSQ), 0, scr, r - mi * I_SQ, lane); }
    }
    const int gt = F.vcu * 512 + F.tid, NT = F.G * 512;
    for (int i = gt; i < MTOT * (D / 4); i += NT) { const int row = i >> 9, c = (i & 511) * 4;
        const float* src = row < MLAT ? a.in[I_X] + (size_t)row * D + c : a.in[I_CTX] + (size_t)(row - MLAT) * D + c;
        *(f32x4*)((float*)(ws + WS_X) + (size_t)row * D + c) = *(const f32x4*)src; }
    for (int i = gt; i < 4352 * 64; i += NT) { const int r = i >> 6, j = i & 63;
        float p0, p1, p2; if (r < 4096) { p0 = 256.f; p1 = (float)(r >> 6); p2 = (float)(r & 63); } else { p0 = (float)(r - 4096); p1 = 0.f; p2 = 0.f; }
        float ang; if (j < 16) ang = p0 * powf(10000.f, -(float)j / 16.f); else if (j < 40) ang = p1 * powf(10000.f, -(float)(j - 16) / 24.f); else ang = p2 * powf(10000.f, -(float)(j - 40) / 24.f);
        ((float*)(ws + WS_ROPE))[i] = cosf(ang); ((float*)(ws + WS_ROPE))[4352 * 64 + i] = sinf(ang); }
}

__device__ __forceinline__ void modreduce_phase(const Frame& F, const Args& a) {
    const int gt = F.vcu * 512 + F.tid, NT = F.G * 512;
    for (int i = gt; i < 12 * NMODV / 4; i += NT) { const int e = i * 4, l = e / (3 * NMODV), n = e % NMODV;
        f32x4 acc = *(const f32x4*)(a.in[I_ADAB] + (size_t)l * NMODV + n);
#pragma unroll
        for (int ks = 0; ks < 16; ++ks) acc += *(const f32x4*)((const float*)(F.ws + WS_PART) + (size_t)ks * 12 * NMODV + e);
        *(f32x4*)((float*)(F.ws + WS_MOD) + e) = acc; }
}
__device__ __forceinline__ void norm_phase(const Frame& F, const Args& a, int l, int idx, int M) {
    const int gw = F.vcu * 8 + F.wave, NGW = F.G * 8, lane = F.lane;
    const float* gp = a.in[I_NORMG] + (size_t)(l * 3 + idx) * D;
    for (int row = gw; row < M; row += NGW) {
        const int b = row < SEQ ? 0 : (row < MLAT ? 1 : 2);
        const float* mod = (const float*)(F.ws + WS_MOD) + (size_t)((l * 3 + b) * 9 + 3 * idx) * D;
        const f32x4* xr = (const f32x4*)((const float*)(F.ws + WS_X) + (size_t)row * D) + lane;
        f32x4 v[8]; float s = 0.f;
#pragma unroll
        for (int j = 0; j < 8; ++j) { v[j] = xr[64 * j]; s += (v[j][0] * v[j][0] + v[j][1] * v[j][1]) + (v[j][2] * v[j][2] + v[j][3] * v[j][3]); }
        const float rstd = 1.0f / sqrtf(wave_sum(s) * (1.0f / D) + EPS);
        u32x2* o = (u32x2*)((bf16_t*)(F.ws + WS_H) + (size_t)row * D) + lane;
#pragma unroll
        for (int j = 0; j < 8; ++j) { const int c = 4 * lane + 256 * j; const f32x4 g = *(const f32x4*)(gp + c), sh = *(const f32x4*)(mod + c), sc = *(const f32x4*)(mod + D + c);
            const f32x4 y = v[j] * rstd * g * (sc + 1.0f) + sh; u32x2 w; w.x = cvt_pk_bf16(y[0], y[1]); w.y = cvt_pk_bf16(y[2], y[3]); o[64 * j] = w; }
    }
}
__device__ __forceinline__ void final_phase(const Frame& F, const Args& a) {
    const int gw = F.vcu * 8 + F.wave, NGW = F.G * 8, lane = F.lane;
    const float* gp = a.in[I_FINALG];
    for (int row = gw; row < MLAT; row += NGW) {
        const f32x4* xr = (const f32x4*)((const float*)(F.ws + WS_X) + (size_t)row * D) + lane;
        f32x4 v[8]; float s = 0.f;
#pragma unroll
        for (int j = 0; j < 8; ++j) { v[j] = xr[64 * j]; s += (v[j][0] * v[j][0] + v[j][1] * v[j][1]) + (v[j][2] * v[j][2] + v[j][3] * v[j][3]); }
        const float rstd = 1.0f / sqrtf(wave_sum(s) * (1.0f / D) + EPS);
        f32x4* o = (f32x4*)(a.out + (size_t)row * D) + lane;
#pragma unroll
        for (int j = 0; j < 8; ++j) { const f32x4 g = *(const f32x4*)(gp + 4 * lane + 256 * j); o[64 * j] = v[j] * rstd * g; }
    }
}
__device__ __forceinline__ void dbg_dump(const Frame& F, const Args& a, size_t off, size_t nbytes) {
    const int gt = F.vcu * 512 + F.tid, NT = F.G * 512; const size_t n = nbytes / 2; const unsigned short* p = (const unsigned short*)(F.ws + off);
    for (int i = gt; i < MLAT * D; i += NT) { float s = 0.f; for (size_t j = i; j < n; j += (size_t)MLAT * D) s += (float)p[j]; a.out[i] = s; }
}
__device__ __forceinline__ void row_nbrs(int row, bool& hasL, bool& hasR) {
    if (row < MLAT) { const int t = row & 63; hasL = t > 0; hasR = t < 63; } else { const int t = (row - MLAT) & 255; hasL = t > 0; hasR = t < 255; }
}
__device__ __forceinline__ void scconv_phase(const Frame& F, const Args& a, int m, int M) {
    const int gt = F.vcu * 512 + F.tid, NT = F.G * 512;
    const bf16_t* BG = (const bf16_t*)(F.ws + WS_BG); const bf16_t* T = (const bf16_t*)(F.ws + WS_T); bf16_t* O = (bf16_t*)(F.ws + WS_MRG);
    const float* cw = a.in[I_SCCW] + (size_t)m * 3 * D;
    for (int it = gt; it < M * 256; it += NT) { const int row = it >> 8, c0 = (it & 255) * 8; bool hl, hr; row_nbrs(row, hl, hr);
        const size_t off = (size_t)row * D + c0; const u32x4 z4 = {0u, 0u, 0u, 0u};
        const u32x4 tc = *(const u32x4*)(T + off), tl = hl ? *(const u32x4*)(T + off - D) : z4, tr = hr ? *(const u32x4*)(T + off + D) : z4, bg = *(const u32x4*)(BG + off);
        float fc[8], fl[8], fr_[8], fb[8], o[8]; unpack8(tc, fc); unpack8(tl, fl); unpack8(tr, fr_); unpack8(bg, fb);
#pragma unroll
        for (int j = 0; j < 8; ++j) o[j] = fb[j] * (cw[c0 + j] * fl[j] + cw[D + c0 + j] * fc[j] + cw[2 * D + c0 + j] * fr_[j]);
        *(u32x4*)(O + off) = pack8(o); }
}
__device__ __forceinline__ void conv8(const bf16_t* XBC, const float* cw, const float* cb, int row, int col, float* o) {
#ifdef DBG_E2
    { const u32x4 xc0 = *(const u32x4*)(XBC + (size_t)row * XBCW + col); unpack8(xc0, o); return; }
#endif
    bool hl, hr; row_nbrs(row, hl, hr); const size_t off = (size_t)row * XBCW + col; const u32x4 z4 = {0u, 0u, 0u, 0u};
    const u32x4 xc = *(const u32x4*)(XBC + off), xl = hl ? *(const u32x4*)(XBC + off - XBCW) : z4, xr = hr ? *(const u32x4*)(XBC + off + XBCW) : z4;
    float fc[8], fl[8], fr_[8]; unpack8(xc, fc); unpack8(xl, fl); unpack8(xr, fr_);
#pragma unroll
    for (int j = 0; j < 8; ++j) o[j] = silu_f(cw[col + j] * fl[j] + cw[XBCW + col + j] * fc[j] + cw[2 * XBCW + col + j] * fr_[j] + cb[col + j]);
}

template <int NK> __device__ __forceinline__ f32x4 tile_mma(const LAS bf16_t* L, int ldl, const LAS bf16_t* R, int ldr, f32x4 acc, int fr, int fq) {
#pragma unroll
    for (int kk = 0; kk < NK; ++kk) { const bf16x8 l = *(const LAS bf16x8*)(L + fr * ldl + kk * 32 + 8 * fq); const bf16x8 r = *(const LAS bf16x8*)(R + fr * ldr + kk * 32 + 8 * fq);
        acc = __builtin_amdgcn_mfma_f32_16x16x32_bf16(r, l, acc, 0, 0, 0); }
    return acc;
}
__device__ __forceinline__ int chunk_row0(int cc, int b) { return cc < 64 ? b * SEQ + cc * 64 : MLAT + b * CTXL + (cc - 64) * 64; }
__device__ __forceinline__ void st4(bf16_t* p, const f32x4 v) { u32x2 w; w.x = cvt_pk_bf16(v[0], v[1]); w.y = cvt_pk_bf16(v[2], v[3]); *(u32x2*)p = w; }
__device__ __forceinline__ void st4l(LAS bf16_t* p, const f32x4 v) { u32x2 w; w.x = cvt_pk_bf16(v[0], v[1]); w.y = cvt_pk_bf16(v[2], v[3]); *(LAS u32x2*)p = w; }

__device__ __forceinline__ void retA_unit(const Frame& F, const Args& a, int m, int cc, int b, int h) {
    LAS bf16_t* Ktf = (LAS bf16_t*)F.lds; LAS bf16_t* Ktb = Ktf + 128 * 72; LAS bf16_t* Vt = Ktb + 128 * 72;
    const int r0 = chunk_row0(cc, b), tid = F.tid, w = F.wave, fr = F.lane & 15, fq = F.lane >> 4;
    const float lgf = a.in[I_RLD][m * 16 + h], lgb = a.in[I_RLD][m * 16 + 8 + h];
    const bf16_t* Kg = (const bf16_t*)(F.ws + WS_K); const bf16_t* Vg = (const bf16_t*)(F.ws + WS_V);
#pragma unroll
    for (int i = 0; i < 2; ++i) { const int idx = tid + i * 512, k = idx >> 4, d0 = (idx & 15) * 8;
        const u32x4 kv = *(const u32x4*)(Kg + (size_t)(r0 + k) * 1024 + h * 128 + d0), vv = *(const u32x4*)(Vg + (size_t)(r0 + k) * 1024 + h * 128 + d0);
        float kf[8], vf[8]; unpack8(kv, kf); unpack8(vv, vf); const float df = fexp(lgf * (float)(63 - k)), db = fexp(lgb * (float)k);
#pragma unroll
        for (int j = 0; j < 8; ++j) { Ktf[(d0 + j) * 72 + k] = f2bf(kf[j] * df); Ktb[(d0 + j) * 72 + k] = f2bf(kf[j] * db); Vt[(d0 + j) * 72 + k] = f2bf(vf[j]); } }
    __syncthreads();
    bf16_t* U = (bf16_t*)(F.ws + WS_RST) + (size_t)(((cc * 2 + b) * 8 + h) * 2) * 16384;
#pragma unroll
    for (int dir = 0; dir < 2; ++dir) { const LAS bf16_t* Kt = dir ? Ktb : Ktf;
#pragma unroll
        for (int dt = 0; dt < 8; ++dt) { f32x4 acc = {0.f, 0.f, 0.f, 0.f}; acc = tile_mma<2>(Vt + 16 * w * 72, 72, Kt + 16 * dt * 72, 72, acc, fr, fq);
            st4(U + (size_t)dir * 16384 + (16 * w + fr) * 128 + 16 * dt + 4 * fq, acc); } }
    __syncthreads();
}
__device__ __forceinline__ void dt_scan(const Frame& F, const Args& a, int m, int r0, int hd, float& dtf, float& dtb, float& cf, float& sb) {
    const float* DT = (const float*)(F.ws + WS_DT); const int lane = F.lane;
    dtf = DT[(size_t)(r0 + lane) * 32 + hd]; dtb = DT[(size_t)(r0 + lane) * 32 + 16 + hd];
    const float af = -expf(a.in[I_SALOG][m * 32 + hd]), ab = -expf(a.in[I_SALOG][m * 32 + 16 + hd]);
    float p = dtf, s = dtb;
#pragma unroll
    for (int o = 1; o < 64; o <<= 1) { const float t = __shfl_up(p, o); if (lane >= o) p += t; const float t2 = __shfl_down(s, o); if (lane + o < 64) s += t2; }
    cf = af * p; sb = ab * s;
}
__device__ __forceinline__ void ssdA_unit(const Frame& F, const Args& a, int m, int cc, int b, int hd) {
    LAS bf16_t* Bt = (LAS bf16_t*)F.lds; LAS bf16_t* xtf = Bt + 128 * 72; LAS bf16_t* xtb = xtf + 64 * 72; LAS float* tef = (LAS float*)(xtb + 64 * 72); LAS float* teb = tef + 64;
    const int r0 = chunk_row0(cc, b), tid = F.tid, w = F.wave, lane = F.lane, fr = lane & 15, fq = lane >> 4, grp = hd >> 3;
    if (w == 0) { float dtf, dtb, cf, sb; dt_scan(F, a, m, r0, hd, dtf, dtb, cf, sb);
        const float cf63 = __shfl(cf, 63), sb0 = __shfl(sb, 0);
#ifdef DBG_E1
        tef[lane] = 1.0f; teb[lane] = 0.5f;
#else
        tef[lane] = fexp(cf63 - cf) * dtf; teb[lane] = fexp(sb0 - sb) * dtb;
#endif
        if (lane == 0) { float* cd = (float*)(F.ws + WS_CHDEC) + (size_t)((cc * 2 + b) * 2) * 16 + hd; cd[0] = fexp(cf63); cd[16] = fexp(sb0); } }
    __syncthreads();
    const bf16_t* XBC = (const bf16_t*)(F.ws + WS_XBC); const float* cw = a.in[I_MCW] + (size_t)m * 3 * XBCW; const float* cbp = a.in[I_MCB] + (size_t)m * XBCW;
#pragma unroll
    for (int i = 0; i < 2; ++i) { const int idx = tid + i * 512, k = idx >> 4, n0 = (idx & 15) * 8; float v[8]; conv8(XBC, cw, cbp, r0 + k, 1024 + grp * 128 + n0, v);
#pragma unroll
        for (int j = 0; j < 8; ++j) Bt[(n0 + j) * 72 + k] = f2bf(v[j]); }
    { const int k = tid >> 3, p0 = (tid & 7) * 8; float v[8]; conv8(XBC, cw, cbp, r0 + k, hd * 64 + p0, v); const float tf = tef[k], tb = teb[k];
#pragma unroll
        for (int j = 0; j < 8; ++j) { xtf[(p0 + j) * 72 + k] = f2bf(v[j] * tf); xtb[(p0 + j) * 72 + k] = f2bf(v[j] * tb); } }
    __syncthreads();
    bf16_t* U = (bf16_t*)(F.ws + WS_SST) + (size_t)(((cc * 2 + b) * 16 + hd) * 2) * 8192;
    const int tp = w >> 1;
#pragma unroll
    for (int dir = 0; dir < 2; ++dir) { const LAS bf16_t* xt = dir ? xtb : xtf;
#pragma unroll
        for (int t = 0; t < 4; ++t) { const int tn = (w & 1) * 4 + t; f32x4 acc = {0.f, 0.f, 0.f, 0.f}; acc = tile_mma<2>(xt + 16 * tp * 72, 72, Bt + 16 * tn * 72, 72, acc, fr, fq);
            st4(U + (size_t)dir * 8192 + (16 * tp + fr) * 128 + 16 * tn + 4 * fq, acc); } }
    __syncthreads();
}
__device__ __forceinline__ void scanA_phase(const Frame& F, const Args& a, int m) {
    for (int u = F.vcu; u < 68 * 16; u += F.G) retA_unit(F, a, m, u >> 4, (u >> 3) & 1, u & 7);
    for (int u = F.vcu; u < 68 * 32; u += F.G) ssdA_unit(F, a, m, u >> 5, (u >> 4) & 1, u & 15);
}
__device__ __forceinline__ void scanB_phase(const Frame& F, const Args& a, int m) {
    const int gt = F.vcu * 512 + F.tid, NT = F.G * 512;
    for (int g = gt; g < 131072; g += NT) {
        const bool isret = g < 65536; const int e = (isret ? g : g - 65536) * 8;
        bf16_t* base; float decc = 0.f; const float* chd = nullptr; int dir;
        if (isret) { const int idx = e >> 14; dir = idx & 1; const int h = (idx >> 1) & 7; decc = fexp(64.f * a.in[I_RLD][m * 16 + dir * 8 + h]); base = (bf16_t*)(F.ws + WS_RST) + e; }
        else { const int idx = e >> 13; dir = idx & 1; const int hd = (idx >> 1) & 15, b = idx >> 5; base = (bf16_t*)(F.ws + WS_SST) + e; chd = (const float*)(F.ws + WS_CHDEC) + (b * 2 + dir) * 16 + hd; }
        float car[8];
#pragma unroll
        for (int j = 0; j < 8; ++j) car[j] = 0.f;
#pragma nounroll
        for (int s0 = 0; s0 < 68; s0 += 4) {
            u32x4 uv[4]; float dc[4]; int ccs[4];
#pragma unroll
            for (int q = 0; q < 4; ++q) { const int s = s0 + q; ccs[q] = dir ? 67 - s : (s < 4 ? 64 + s : s - 4); uv[q] = *(const u32x4*)(base + (size_t)ccs[q] * 524288); dc[q] = isret ? decc : chd[ccs[q] * 64]; }
#pragma unroll
            for (int q = 0; q < 4; ++q) { float uf[8]; unpack8(uv[q], uf); *(u32x4*)(base + (size_t)ccs[q] * 524288) = pack8(car);
#pragma unroll
                for (int j = 0; j < 8; ++j) car[j] = car[j] * dc[q] + uf[j]; }
        }
    }
}
__device__ __forceinline__ void retC_unit(const Frame& F, const Args& a, int m, int cc, int b, int h) {
    LAS bf16_t* Qs = (LAS bf16_t*)F.lds; LAS bf16_t* Ks = Qs + 64 * 136; LAS bf16_t* Vt = Ks + 64 * 136; LAS bf16_t* P = Vt + 128 * 72; LAS bf16_t* Sf = P + 64 * 72; LAS bf16_t* Sb = Sf + 128 * 136;
    LAS float* Ob = (LAS float*)Sf;
    const int r0 = chunk_row0(cc, b), tid = F.tid, w = F.wave, lane = F.lane, fr = lane & 15, fq = lane >> 4;
    const float lgf = a.in[I_RLD][m * 16 + h], lgb = a.in[I_RLD][m * 16 + 8 + h];
    const bf16_t* Qg = (const bf16_t*)(F.ws + WS_Q); const bf16_t* Kg = (const bf16_t*)(F.ws + WS_K); const bf16_t* Vg = (const bf16_t*)(F.ws + WS_V);
    const bf16_t* St = (const bf16_t*)(F.ws + WS_RST) + (size_t)(((cc * 2 + b) * 8 + h) * 2) * 16384;
#pragma unroll
    for (int i = 0; i < 2; ++i) { const int idx = tid + i * 512, k = idx >> 4, d0 = (idx & 15) * 8; const size_t go = (size_t)(r0 + k) * 1024 + h * 128 + d0;
        *(LAS u32x4*)(Qs + k * 136 + d0) = *(const u32x4*)(Qg + go); *(LAS u32x4*)(Ks + k * 136 + d0) = *(const u32x4*)(Kg + go);
        const u32x4 vv = *(const u32x4*)(Vg + go); const unsigned short* vs = (const unsigned short*)&vv;
        Vt[(d0 + 0) * 72 + k] = (bf16_t)(vv.x & 0xffffu); Vt[(d0 + 1) * 72 + k] = (bf16_t)(vv.x >> 16); Vt[(d0 + 2) * 72 + k] = (bf16_t)(vv.y & 0xffffu); Vt[(d0 + 3) * 72 + k] = (bf16_t)(vv.y >> 16);
        Vt[(d0 + 4) * 72 + k] = (bf16_t)(vv.z & 0xffffu); Vt[(d0 + 5) * 72 + k] = (bf16_t)(vv.z >> 16); Vt[(d0 + 6) * 72 + k] = (bf16_t)(vv.w & 0xffffu); Vt[(d0 + 7) * 72 + k] = (bf16_t)(vv.w >> 16); (void)vs; }
#pragma unroll
    for (int i = 0; i < 4; ++i) { const int idx = tid + i * 512, v = idx >> 4, d0 = (idx & 15) * 8;
        *(LAS u32x4*)(Sf + v * 136 + d0) = *(const u32x4*)(St + (size_t)v * 128 + d0); *(LAS u32x4*)(Sb + v * 136 + d0) = *(const u32x4*)(St + 16384 + (size_t)v * 128 + d0); }
    __syncthreads();
    const int tq = w >> 1, q = 16 * tq + fr;
#pragma unroll
    for (int t = 0; t < 2; ++t) { const int tk = (w & 1) * 2 + t; f32x4 acc = {0.f, 0.f, 0.f, 0.f}; acc = tile_mma<4>(Qs + 16 * tq * 136, 136, Ks + 16 * tk * 136, 136, acc, fr, fq);
#pragma unroll
        for (int i = 0; i < 4; ++i) { const int k = 16 * tk + 4 * fq + i, d = q - k; const float dcm = (d >= 0 ? fexp(lgf * (float)d) : 0.f) + (d <= 0 ? fexp(lgb * (float)(-d)) : 0.f); acc[i] *= dcm; }
        st4l(P + q * 72 + 16 * tk + 4 * fq, acc); }
    __syncthreads();
    f32x4 o[4]; const float qdf = fexp(lgf * (float)(q + 1)), qdb = fexp(lgb * (float)(64 - q));
#pragma unroll
    for (int t = 0; t < 4; ++t) { const int tv = (w & 1) * 4 + t; const f32x4 z = {0.f, 0.f, 0.f, 0.f};
        const f32x4 aP = tile_mma<2>(P + 16 * tq * 72, 72, Vt + 16 * tv * 72, 72, z, fr, fq);
        const f32x4 aF = tile_mma<4>(Qs + 16 * tq * 136, 136, Sf + 16 * tv * 136, 136, z, fr, fq);
        const f32x4 aB = tile_mma<4>(Qs + 16 * tq * 136, 136, Sb + 16 * tv * 136, 136, z, fr, fq);
        o[t] = aP + aF * qdf + aB * qdb; }
    __syncthreads();
#pragma unroll
    for (int t = 0; t < 4; ++t) { const int tv = (w & 1) * 4 + t; *(LAS f32x4*)(Ob + q * 132 + 16 * tv + 4 * fq) = o[t]; }
    __syncthreads();
    { const int qq = tid >> 3, v0 = (tid & 7) * 16, row = r0 + qq; f32x4 x[4]; float s = 0.f;
#pragma unroll
        for (int j = 0; j < 4; ++j) { x[j] = *(const LAS f32x4*)(Ob + qq * 132 + v0 + 4 * j); s += (x[j][0] + x[j][1]) + (x[j][2] + x[j][3]); }
        s += __shfl_xor(s, 1); s += __shfl_xor(s, 2); s += __shfl_xor(s, 4); const float mean = s * (1.0f / 128.f); float ss = 0.f;
#pragma unroll
        for (int j = 0; j < 4; ++j) { x[j] = x[j] - mean; ss += (x[j][0] * x[j][0] + x[j][1] * x[j][1]) + (x[j][2] * x[j][2] + x[j][3] * x[j][3]); }
        ss += __shfl_xor(ss, 1); ss += __shfl_xor(ss, 2); ss += __shfl_xor(ss, 4); const float rstd = 1.0f / sqrtf(ss * (1.0f / 128.f) + EPS);
        const bf16_t* Gg = (const bf16_t*)(F.ws + WS_G) + (size_t)row * 1024 + h * 128 + v0; const float* gn = a.in[I_RGN] + (size_t)m * 1024 + h * 128 + v0;
        bf16_t* op = (bf16_t*)(F.ws + WS_MRG) + (size_t)row * D + h * 128 + v0;
#pragma unroll
        for (int hf = 0; hf < 2; ++hf) { float gf[8], ov[8]; unpack8(*(const u32x4*)(Gg + 8 * hf), gf);
#pragma unroll
            for (int j = 0; j < 8; ++j) ov[j] = x[2 * hf + (j >> 2)][j & 3] * rstd * gn[8 * hf + j] * silu_f(gf[j]);
            *(u32x4*)(op + 8 * hf) = pack8(ov); } }
    __syncthreads();
}
__device__ __forceinline__ void ssdC_unit(const Frame& F, const Args& a, int m, int cc, int b, int hd) {
    LAS bf16_t* Cs = (LAS bf16_t*)F.lds; LAS bf16_t* Bs = Cs + 64 * 136; LAS bf16_t* xt = Bs + 64 * 136; LAS bf16_t* W = xt + 64 * 72; LAS bf16_t* Sf = W + 64 * 72; LAS bf16_t* Sb = Sf + 64 * 136;
    LAS float* cfa = (LAS float*)(Sb + 64 * 136); LAS float* sba = cfa + 64; LAS float* dfa = sba + 64; LAS float* dba = dfa + 64;
    const int r0 = chunk_row0(cc, b), tid = F.tid, w = F.wave, lane = F.lane, fr = lane & 15, fq = lane >> 4, grp = hd >> 3;
    if (w == 0) { float dtf, dtb, cf, sb; dt_scan(F, a, m, r0, hd, dtf, dtb, cf, sb); cfa[lane] = cf; sba[lane] = sb; dfa[lane] = dtf; dba[lane] = dtb; }
    const bf16_t* XBC = (const bf16_t*)(F.ws + WS_XBC); const float* cw = a.in[I_MCW] + (size_t)m * 3 * XBCW; const float* cbp = a.in[I_MCB] + (size_t)m * XBCW;
    const bf16_t* St = (const bf16_t*)(F.ws + WS_SST) + (size_t)(((cc * 2 + b) * 16 + hd) * 2) * 8192;
#pragma unroll
    for (int i = 0; i < 2; ++i) { const int idx = tid + i * 512, k = idx >> 4, n0 = (idx & 15) * 8; float v[8];
        conv8(XBC, cw, cbp, r0 + k, 1280 + grp * 128 + n0, v); *(LAS u32x4*)(Cs + k * 136 + n0) = pack8(v);
        conv8(XBC, cw, cbp, r0 + k, 1024 + grp * 128 + n0, v); *(LAS u32x4*)(Bs + k * 136 + n0) = pack8(v);
        *(LAS u32x4*)(Sf + k * 136 + n0) = *(const u32x4*)(St + (size_t)k * 128 + n0); *(LAS u32x4*)(Sb + k * 136 + n0) = *(const u32x4*)(St + 8192 + (size_t)k * 128 + n0); }
    { const int k = tid >> 3, p0 = (tid & 7) * 8; float v[8]; conv8(XBC, cw, cbp, r0 + k, hd * 64 + p0, v);
#pragma unroll
        for (int j = 0; j < 8; ++j) xt[(p0 + j) * 72 + k] = f2bf(v[j]); }
    __syncthreads();
    const int tq = w >> 1, q = 16 * tq + fr; const float cfq = cfa[q], sbq = sba[q];
#pragma unroll
    for (int t = 0; t < 2; ++t) { const int tk = (w & 1) * 2 + t; f32x4 acc = {0.f, 0.f, 0.f, 0.f}; acc = tile_mma<4>(Cs + 16 * tq * 136, 136, Bs + 16 * tk * 136, 136, acc, fr, fq);
#pragma unroll
        for (int i = 0; i < 4; ++i) { const int k = 16 * tk + 4 * fq + i; const float wd = (k <= q ? fexp(cfq - cfa[k]) * dfa[k] : 0.f) + (k >= q ? fexp(sbq - sba[k]) * dba[k] : 0.f); acc[i] *= wd; }
        st4l(W + q * 72 + 16 * tk + 4 * fq, acc); }
    __syncthreads();
    const float ef = fexp(cfq), eb = fexp(sbq), Dh = a.in[I_SD][m * 16 + hd]; const int row = r0 + q; float ssq = 0.f;
#pragma unroll
    for (int t = 0; t < 2; ++t) { const int tp = (w & 1) * 2 + t, p = 16 * tp + 4 * fq; const f32x4 z = {0.f, 0.f, 0.f, 0.f};
        const f32x4 aI = tile_mma<2>(W + 16 * tq * 72, 72, xt + 16 * tp * 72, 72, z, fr, fq);
        const f32x4 aF = tile_mma<4>(Cs + 16 * tq * 136, 136, Sf + 16 * tp * 136, 136, z, fr, fq);
        const f32x4 aB = tile_mma<4>(Cs + 16 * tq * 136, 136, Sb + 16 * tp * 136, 136, z, fr, fq);
        f32x4 y = aI + aF * ef + aB * eb;
        const u32x2 zz = *(const u32x2*)((const bf16_t*)(F.ws + WS_Z) + (size_t)row * 1024 + hd * 64 + p);
        const float zf[4] = {__uint_as_float(zz.x << 16), __uint_as_float(zz.x & 0xffff0000u), __uint_as_float(zz.y << 16), __uint_as_float(zz.y & 0xffff0000u)};
#pragma unroll
        for (int i = 0; i < 4; ++i) { y[i] = (y[i] + Dh * bf2f(xt[(p + i) * 72 + q])) * silu_f(zf[i]); ssq += y[i] * y[i]; }
        st4((bf16_t*)(F.ws + WS_MRG) + (size_t)row * D + 1024 + hd * 64 + p, y); }
    ssq += __shfl_xor(ssq, 16); ssq += __shfl_xor(ssq, 32);
    if (fq == 0) ((float*)(F.ws + WS_SSQ))[(size_t)row * 32 + hd * 2 + (w & 1)] = ssq;
    __syncthreads();
}
__device__ __forceinline__ void scanC_phase(const Frame& F, const Args& a, int m, int nC) {
    for (int u = F.vcu; u < nC * 16; u += F.G) retC_unit(F, a, m, u >> 4, (u >> 3) & 1, u & 7);
    for (int u = F.vcu; u < nC * 32; u += F.G) ssdC_unit(F, a, m, u >> 5, (u >> 4) & 1, u & 15);
}
__device__ __forceinline__ void ssdnorm_phase(const Frame& F, const Args& a, int m, int M) {
    const int gw = F.vcu * 8 + F.wave, NGW = F.G * 8, lane = F.lane;
    const float* ng = a.in[I_SNG] + (size_t)m * 1024 + lane * 16;
    for (int row = gw; row < M; row += NGW) {
        float s = ((const float*)(F.ws + WS_SSQ))[(size_t)row * 32 + (lane & 31)];
        s += __shfl_xor(s, 1); s += __shfl_xor(s, 2); s += __shfl_xor(s, 4); s += __shfl_xor(s, 8); s += __shfl_xor(s, 16);
        const float rstd = 1.0f / sqrtf(s * (1.0f / 1024.f) + EPS);
        bf16_t* p = (bf16_t*)(F.ws + WS_MRG) + (size_t)row * D + 1024 + lane * 16;
#pragma unroll
        for (int hf = 0; hf < 2; ++hf) { float f[8]; unpack8(*(const u32x4*)(p + 8 * hf), f);
#pragma unroll
            for (int j = 0; j < 8; ++j) f[j] *= rstd * ng[8 * hf + j];
            *(u32x4*)(p + 8 * hf) = pack8(f); }
    }
}

constexpr int N_PHASES = 55;
__global__ void __launch_bounds__(512, 2) fwd(Args args) {
    __shared__ __attribute__((aligned(16))) unsigned char lds_raw[LDS_BYTES];
    LAS unsigned char* const lds0 = (LAS unsigned char*)lds_raw;
    const int G = gridDim.x; int vcu; { const int bx = blockIdx.x; vcu = (G % 8 == 0) ? (bx % 8) * (G / 8) + bx / 8 : bx; }
    volatile LAS unsigned* MISC = (volatile LAS unsigned*)(lds0 + LDS_MISC);
    if (threadIdx.x < 64) MISC[threadIdx.x] = 0u;
    __syncthreads();
    const int lo = args.ph_lo, hi = args.ph_hi;
    XcdBarrier bar; bar.bar = (unsigned*)(args.ws + WS_CTL) + 4096; bar.x = 0; bar.st = MISC + 8;
    if (hi - lo > 1) bar = xcd_barrier_post((unsigned*)(args.ws + WS_CTL) + 4096, MISC + 8);
#define IN(k) (lo <= (k) && (k) < hi)
#define SEAM(k) do { if (IN(k) && IN((k) + 1)) xcd_barrier(bar); } while (0)
#define FRAME() const Frame F = mk_frame(args.ws, lds0, G, vcu); unsigned char* const ws = F.ws
    if (IN(0)) { FRAME(); (void)ws; prologue(F, args); }
    SEAM(0);
    if (IN(1)) { FRAME(); (void)ws; modreduce_phase(F, args); }
    SEAM(1);
#pragma nounroll
    for (int l = 0; l < 4; ++l) {
        const int pb = 2 + 13 * l, m = l >> 1; const bool even = (l & 1) == 0;
        const int Min = l <= 2 ? MTOT : MLAT, Mout = l < 2 ? MTOT : MLAT;
#pragma nounroll
        for (int half = 0; half < 2; ++half) {
            const int p0 = pb + 10 * half, Mf = half ? Mout : Min, fi = l * 2 + half;
            if (IN(p0)) { FRAME(); (void)ws; norm_phase(F, args, l, half ? 2 : 0, Mf); }
            SEAM(p0);
            if (IN(p0 + 1)) { FRAME(); pg8::Gemm g{(const bf16_t*)(ws + WS_H), (const bf16_t*)(ws + WS_WUP + fi * SZ_WUP), D}; pg8::StaticOrder S; S.init(Mf, 2 * DFF, G, (int)blockIdx.x);
                pg8::EpiUp E{(bf16_t*)(ws + WS_HID)}; pg8::gemm_phase<pg8::EpiUp, pg8::StaticOrder, true, true>(F.lds, F.tid, g, S, E); }
            SEAM(p0 + 1);
            if (IN(p0 + 2)) { FRAME(); pg8::Gemm g{(const bf16_t*)(ws + WS_HID), (const bf16_t*)(ws + WS_WDN + fi * SZ_WDN), DFF}; pg8::StaticOrder S; S.init(Mf, D, G, (int)blockIdx.x);
                pg8::EpiRes E{(float*)(ws + WS_X), (const float*)(ws + WS_MOD) + (size_t)(l * 27 + (half ? 8 : 2)) * D, 0.5f}; pg8::gemm_phase<pg8::EpiRes, pg8::StaticOrder, true, true>(F.lds, F.tid, g, S, E); }
            SEAM(p0 + 2);
            if (half == 0) {
                if (IN(pb + 3)) { FRAME(); (void)ws; norm_phase(F, args, l, 1, Min); }
                SEAM(pb + 3);
                if (even) {
                    if (IN(pb + 4)) { FRAME(); pg8::Gemm g{(const bf16_t*)(ws + WS_H), (const bf16_t*)(ws + WS_WMI + m * SZ_WMI), D}; pg8::StaticOrder S; S.init(Min, 6912, G, (int)blockIdx.x);
                        pg8::EpiInEven E{(bf16_t*)(ws + WS_Q), (float*)(ws + WS_DT),
                            (const float*)(ws + WS_ROPE), (const float*)(ws + WS_ROPE) + 4352 * 64, args.in[I_SDTB] + m * 32};
                        pg8::gemm_phase<pg8::EpiInEven, pg8::StaticOrder, true, true>(F.lds, F.tid, g, S, E); }
                    SEAM(pb + 4);
                    if (IN(pb + 5)) { FRAME(); (void)ws; scanA_phase(F, args, m); }
                    SEAM(pb + 5);
                    if (IN(pb + 6)) { FRAME(); (void)ws; scanB_phase(F, args, m); }
                    SEAM(pb + 6);
                    if (IN(pb + 7)) { FRAME(); (void)ws; scanC_phase(F, args, m, Mout == MTOT ? 68 : 64); }
                    SEAM(pb + 7);
                    if (IN(pb + 8)) { FRAME(); (void)ws; ssdnorm_phase(F, args, m, Mout); }
                    SEAM(pb + 8);
                } else {
                    if (IN(pb + 4)) { FRAME(); pg8::Gemm g{(const bf16_t*)(ws + WS_H), (const bf16_t*)(ws + WS_WSI + m * SZ_WSI), D}; pg8::StaticOrder S; S.init(Mout, 3 * D, G, (int)blockIdx.x);
                        pg8::EpiInOdd E{(bf16_t*)(ws + WS_BG), (bf16_t*)(ws + WS_T)}; pg8::gemm_phase<pg8::EpiInOdd, pg8::StaticOrder, true, true>(F.lds, F.tid, g, S, E); }
                    SEAM(pb + 4);
                    if (IN(pb + 5)) { FRAME(); (void)ws; scconv_phase(F, args, m, Mout); }
                    if (IN(pb + 5) && IN(pb + 9)) xcd_barrier(bar);
                }
                if (IN(pb + 9)) { FRAME(); pg8::Gemm g{(const bf16_t*)(ws + WS_MRG), (const bf16_t*)(ws + (even ? WS_WMO : WS_WSO) + m * SZ_WSQ), D}; pg8::StaticOrder S; S.init(Mout, D, G, (int)blockIdx.x);
                    pg8::EpiRes E{(float*)(ws + WS_X), (const float*)(ws + WS_MOD) + (size_t)(l * 27 + 5) * D, 1.0f}; pg8::gemm_phase<pg8::EpiRes, pg8::StaticOrder, true, true>(F.lds, F.tid, g, S, E); }
                SEAM(pb + 9);
            }
        }
    }
    if (IN(54)) { FRAME(); (void)ws;
#if DBG_DUMP == 1
        dbg_dump(F, args, WS_Q, 5 * SZ_P1 + (size_t)MTOT * XBCW * 2);
#elif DBG_DUMP == 2
        dbg_dump(F, args, WS_DT, (size_t)MTOT * 32 * 4);
#elif DBG_DUMP == 3
        dbg_dump(F, args, WS_RST, 2 * SZ_ST);
#elif DBG_DUMP == 6
        dbg_dump(F, args, WS_RST, SZ_ST);
#elif DBG_DUMP == 7
        dbg_dump(F, args, WS_SST, SZ_ST);
#elif DBG_DUMP == 4
        dbg_dump(F, args, WS_MRG, (size_t)MTOT * D * 2);
#elif DBG_DUMP == 5
        dbg_dump(F, args, WS_SSQ, (size_t)MTOT * 32 * 4);
#else
        final_phase(F, args);
#endif
    }
#undef IN
#undef SEAM
#undef FRAME
}

extern "C" void kernel_launch(void* const* d_in, const int* in_sizes, int n_in, void* d_out, int out_size, void* d_ws, size_t ws_size, hipStream_t stream) {
    static int grid = 0;
    if (grid == 0) {
        if (n_in != 23 || out_size != MLAT * D || ws_size < WS_END) { fprintf(stderr, "kernel_launch: unexpected shapes (n_in %d, out %d, ws %zu < %zu)\n", n_in, out_size, ws_size, (size_t)WS_END); grid = -1; return; }
        int dev = 0, cus = 0, per_cu = 0;
        if (hipGetDevice(&dev) != hipSuccess || hipDeviceGetAttribute(&cus, hipDeviceAttributeMultiprocessorCount, dev) != hipSuccess) { grid = -1; return; }
        if (hipOccupancyMaxActiveBlocksPerMultiprocessor(&per_cu, (const void*)fwd, 512, 0) != hipSuccess || per_cu < 1) fprintf(stderr, "kernel_launch: occupancy query reports %d\n", per_cu);
        (void)hipGetLastError();
        grid = cus;
    }
    if (grid < 0) return;
    (void)hipMemsetAsync((char*)d_ws, 0, ZERO_BYTES, stream);
    Args a{};
    for (int i = 0; i < 23; ++i) a.in[i] = (const float*)d_in[i];
    a.out = (float*)d_out; a.ws = (unsigned char*)d_ws;
#if MK_PER_PHASE
    for (int p = 0; p < N_PHASES; ++p) {
        const int l = (p - 2) / 13, s = (p - 2) % 13;
        if (p >= 2 && p <= 53 && (l & 1) && (s >= 6 && s <= 8)) continue;
        if (p > DBG_MAXPH && p != N_PHASES - 1) continue;
        a.ph_lo = p; a.ph_hi = p + 1;
        hipLaunchKernelGGL(fwd, dim3(grid), dim3(512), 0, stream, a);
    }
#else
    a.ph_lo = 0; a.ph_hi = N_PHASES;
    hipLaunchKernelGGL(fwd, dim3(grid), dim3(512), 0, stream, a);
#endif
}
```

```cpp
#include <hip/hip_runtime.h>
#include <cstdio>
#include <cstdint>

#ifndef MK_PER_PHASE
#define MK_PER_PHASE 0
#endif
#ifndef DBG_MAXPH
#define DBG_MAXPH 99
#endif
#ifndef DBG_DUMP
#define DBG_DUMP 0
#endif

#define LAS __attribute__((address_space(3)))
#define GAS __attribute__((address_space(1)))
typedef unsigned short bf16_t;
typedef short bf16x8 __attribute__((ext_vector_type(8)));
typedef float f32x4 __attribute__((ext_vector_type(4)));
typedef float f32x2 __attribute__((ext_vector_type(2)));
typedef unsigned u32x4 __attribute__((ext_vector_type(4)));
typedef unsigned u32x2 __attribute__((ext_vector_type(2)));

constexpr int D = 2048, SEQ = 4096, CTXL = 256, MLAT = 8192, MTOT = 8704, DFF = 5632, NMODV = 18432;
constexpr int INW = 6688, XBCW = 1536;
constexpr float EPS = 1e-6f;

constexpr size_t MiB = 1u << 20;
constexpr size_t WS_CTL = 0;
constexpr size_t WS_MOD = 1 * MiB;
constexpr size_t ZERO_BYTES = 2 * MiB;
constexpr size_t WS_ROPE = 2 * MiB;
constexpr size_t WS_SSQ = 5 * MiB;
constexpr size_t WS_CHDEC = 7 * MiB;
constexpr size_t WS_DT = 8 * MiB;
constexpr size_t WS_WUP = 16 * MiB;
constexpr size_t SZ_WUP = (size_t)11264 * 2048 * 2;
constexpr size_t WS_WDN = WS_WUP + 8 * SZ_WUP;
constexpr size_t SZ_WDN = (size_t)2048 * 5632 * 2;
constexpr size_t WS_WMI = WS_WDN + 8 * SZ_WDN;
constexpr size_t SZ_WMI = (size_t)6912 * 2048 * 2;
constexpr size_t WS_WMO = WS_WMI + 2 * SZ_WMI;
constexpr size_t SZ_WSQ = (size_t)2048 * 2048 * 2;
constexpr size_t WS_WSI = WS_WMO + 2 * SZ_WSQ;
constexpr size_t SZ_WSI = (size_t)6144 * 2048 * 2;
constexpr size_t WS_WSO = WS_WSI + 2 * SZ_WSI;
constexpr size_t WS_X = WS_WSO + 2 * SZ_WSQ;
constexpr size_t WS_H = WS_X + (size_t)MTOT * D * 4;
constexpr size_t WS_HID = WS_H + (size_t)MTOT * D * 2;
constexpr size_t WS_Q = WS_HID + (size_t)MTOT * DFF * 2;
constexpr size_t SZ_P1 = (size_t)MTOT * 1024 * 2;
constexpr size_t WS_K = WS_Q + SZ_P1, WS_V = WS_K + SZ_P1, WS_G = WS_V + SZ_P1, WS_Z = WS_G + SZ_P1;
constexpr size_t WS_XBC = WS_Z + SZ_P1;
constexpr size_t WS_BG = WS_Q;
constexpr size_t WS_T = WS_Q + (size_t)MTOT * D * 2;
constexpr size_t WS_MRG = WS_XBC + (size_t)MTOT * XBCW * 2;
constexpr size_t WS_RST = WS_MRG + (size_t)MTOT * D * 2;
constexpr size_t SZ_ST = (size_t)68 * 524288 * 2;
constexpr size_t WS_SST = WS_RST + SZ_ST;
constexpr size_t WS_PART = WS_SST + SZ_ST;
constexpr size_t WS_END = WS_PART + (size_t)16 * 12 * NMODV * 4;
static_assert(WS_T + (size_t)MTOT * D * 2 <= WS_MRG, "odd-layer overlay fits");
static_assert(WS_XBC == WS_Q + 5 * SZ_P1, "EpiInEven addresses Q|K|V|G|Z|XBC from one base");
static_assert(WS_WUP % 256 == 0 && WS_X % 256 == 0 && WS_Q % 256 == 0 && WS_RST % 256 == 0, "alignment");

constexpr int LDS_BYTES = 147456;
constexpr int LDS_MISC = 143360;

typedef __bf16 bf16x2_t __attribute__((ext_vector_type(2)));
__device__ __forceinline__ unsigned cvt_pk_bf16(float lo, float hi) { const f32x2 v = {lo, hi}; const bf16x2_t b = __builtin_convertvector(v, bf16x2_t); return __builtin_bit_cast(unsigned, b); }
__device__ __forceinline__ bf16_t f2bf(float f) { return (bf16_t)(cvt_pk_bf16(f, 0.f) & 0xffffu); }
__device__ __forceinline__ float bf2f(bf16_t v) { return __uint_as_float((unsigned)v << 16); }
__device__ __forceinline__ void unpack8(const u32x4 v, float* f) {
    f[0] = __uint_as_float(v.x << 16); f[1] = __uint_as_float(v.x & 0xffff0000u); f[2] = __uint_as_float(v.y << 16); f[3] = __uint_as_float(v.y & 0xffff0000u);
    f[4] = __uint_as_float(v.z << 16); f[5] = __uint_as_float(v.z & 0xffff0000u); f[6] = __uint_as_float(v.w << 16); f[7] = __uint_as_float(v.w & 0xffff0000u); }
__device__ __forceinline__ u32x4 pack8(const float* f) { u32x4 w; w.x = cvt_pk_bf16(f[0], f[1]); w.y = cvt_pk_bf16(f[2], f[3]); w.z = cvt_pk_bf16(f[4], f[5]); w.w = cvt_pk_bf16(f[6], f[7]); return w; }
__device__ __forceinline__ float silu_f(float x) { return x * __builtin_amdgcn_rcpf(1.0f + __builtin_amdgcn_exp2f(-1.4426950408889634f * x)); }
__device__ __forceinline__ float fexp(float x) { return __builtin_amdgcn_exp2f(1.4426950408889634f * x); }

namespace pg8 {
constexpr int BM = 256, BK = 64, HALF = 128, HTB = HALF * BK * 2, STAGE_BYTES = 8 * HTB, NXCD = 8, WGM = 8;
__host__ __device__ __forceinline__ int lds_byte(int r, int c) { const int st = (r >> 4) * 2 + (c >> 5), rr = r & 15, cc = c & 31, ob = rr * 64 + cc * 2; return st * 1024 + (ob ^ (((ob >> 9) & 1) << 5)); }
__host__ __device__ __forceinline__ void stage_rc(int b, int& R, int& C) { const int st = b / 1024, sb = b % 1024, swz = sb ^ (((sb >> 9) & 1) << 5); R = (st >> 1) * 16 + swz / 64; C = (st & 1) * 32 + (swz % 64) / 2; }
__host__ __device__ __forceinline__ int perm32(int rho) { const int n = rho >> 4, i = rho & 15; return 8 * (i >> 2) + 4 * n + (i & 3); }
struct Unit { int pm, pn; };
struct Gemm { const bf16_t* A; const bf16_t* Bt; int K; };
struct StaticOrder {
    int nM, nN, nwg, G, c;
    __host__ __device__ void init(int M, int N, int G_, int c_) { nM = M / BM; nN = N / BM; nwg = nM * nN; G = G_; c = c_; }
    __host__ __device__ bool next(int i, Unit& u) const {
        const long L = (long)i * G + c; if (L >= nwg) return false;
        int wgid = (int)L; { const int q = nwg / NXCD, r = nwg % NXCD, xcd = wgid % NXCD, off = wgid / NXCD; wgid = (xcd < r ? xcd * (q + 1) : r * (q + 1) + (xcd - r) * q) + off; }
        const int nig = WGM * nN, gid = wgid / nig, fm = gid * WGM, gsz = (nM - fm) < WGM ? (nM - fm) : WGM;
        u.pm = fm + ((wgid % nig) % gsz); u.pn = (wgid % nig) / gsz; return true;
    }
    __device__ __forceinline__ void a_ready(const Unit&) const {}
    __device__ __forceinline__ void done(const Unit&) const {}
};
template <class Epi, class Sched, bool ALIGN_EPI = false, bool SP2 = false>
__device__ __forceinline__ void gemm_phase(LAS unsigned char* lds, const int tid, const Gemm g, const Sched& S, const Epi& E) {
    const int wid = __builtin_amdgcn_readfirstlane(tid >> 6), lane = tid & 63, wr = wid >> 2, wc = wid & 3, fr = lane & 15, fq = lane >> 4;
    const int K = g.K, nt = K / BK;
    unsigned voffA[2], voffB[2];
#pragma unroll
    for (int i = 0; i < 2; ++i) { int R, C; stage_rc(tid * 16 + i * 8192, R, C); const int Rb = Epi::PERM ? ((R & ~31) + perm32(R & 31)) : R;
        voffA[i] = (unsigned)(R * K + C) * 2u; voffB[i] = (unsigned)(Rb * K + C) * 2u; }
    const size_t kstep = (size_t)(BK * 2);
    const size_t hstep = (size_t)HALF * K * 2;
    const size_t tstep = 2 * hstep;
    const unsigned ldsw = (unsigned)wid * 1024u;
    const int aoff = lds_byte(wr * 64 + fr, fq * 8), boff = lds_byte(wc * 32 + fr, fq * 8);
#define PG8_SA(b, h) (((b) * 2 + (h)) * HTB)
#define PG8_SB(b, h) ((4 + (b) * 2 + (h)) * HTB)
#define PG8_STAGE(bufoff, gbase, voff) do { _Pragma("unroll") for (int _i = 0; _i < 2; ++_i) \
        __builtin_amdgcn_global_load_lds((const unsigned*)((const char*)(gbase) + (voff)[_i]), (LAS unsigned*)(lds + (bufoff) + ldsw + _i * 8192), 16, 0, 0); } while (0)
#define PG8_LDA(dst, b, h) do { _Pragma("unroll") for (int m = 0; m < 4; ++m) _Pragma("unroll") for (int k = 0; k < 2; ++k) dst[m][k] = *(const LAS bf16x8*)(lds + PG8_SA(b, h) + aoff + m * 2048 + k * 1024); } while (0)
#define PG8_LDB(dst, b, h) do { _Pragma("unroll") for (int n = 0; n < 2; ++n) _Pragma("unroll") for (int k = 0; k < 2; ++k) dst[n][k] = *(const LAS bf16x8*)(lds + PG8_SB(b, h) + boff + n * 2048 + k * 1024); } while (0)
#define PG8_MMA(ai, bj, At, Bt) do { __builtin_amdgcn_s_setprio(1); _Pragma("unroll") for (int m = 0; m < 4; ++m) _Pragma("unroll") for (int n = 0; n < 2; ++n) _Pragma("unroll") for (int k = 0; k < 2; ++k) \
        acc[ai][bj][m][n] = __builtin_amdgcn_mfma_f32_16x16x32_bf16(Bt[n][k], At[m][k], acc[ai][bj][m][n], 0, 0, 0); __builtin_amdgcn_s_setprio(0); } while (0)
#define PG8_WAIT_V(n) asm volatile("s_waitcnt vmcnt(" #n ")" ::: "memory")
#define PG8_WAIT_L(n) asm volatile("s_waitcnt lgkmcnt(" #n ")" ::: "memory")
#define PG8_BAR __builtin_amdgcn_s_barrier()
#define PG8_SCHED __builtin_amdgcn_sched_barrier(0)
    Unit cur, nxt; int ui = 0;
    if (!S.next(0, cur)) return;
    f32x4 acc[2][2][4][2];
#pragma unroll
    for (int a = 0; a < 2; ++a)
#pragma unroll
        for (int b = 0; b < 2; ++b)
#pragma unroll
            for (int m = 0; m < 4; ++m)
#pragma unroll
                for (int n = 0; n < 2; ++n) acc[a][b][m][n] = (f32x4){0.f, 0.f, 0.f, 0.f};
    bf16x8 At[4][2], B0[2][2], B1[2][2];
    const char* cA = (const char*)g.A + (size_t)cur.pm * tstep; const char* cB = (const char*)g.Bt + (size_t)cur.pn * tstep;
    S.a_ready(cur);
    if constexpr (SP2) {
        PG8_STAGE(PG8_SB(0, 0), cB, voffB); PG8_STAGE(PG8_SB(0, 1), cB + hstep, voffB); PG8_STAGE(PG8_SA(0, 0), cA, voffA); PG8_STAGE(PG8_SA(0, 1), cA + hstep, voffA);
        if (wr == 1) PG8_BAR;
        PG8_WAIT_V(2); PG8_BAR;
        PG8_STAGE(PG8_SB(1, 0), cB + kstep, voffB); PG8_STAGE(PG8_SA(1, 0), cA + kstep, voffA); PG8_STAGE(PG8_SB(1, 1), cB + hstep + kstep, voffB);
        PG8_WAIT_V(6); PG8_BAR;
    } else {
        PG8_STAGE(PG8_SB(0, 0), cB, voffB); PG8_STAGE(PG8_SA(0, 0), cA, voffA); PG8_STAGE(PG8_SB(0, 1), cB + hstep, voffB); PG8_STAGE(PG8_SA(0, 1), cA + hstep, voffA);
        if (wr == 1) PG8_BAR;
        PG8_WAIT_V(4); PG8_BAR;
        PG8_STAGE(PG8_SB(1, 0), cB + kstep, voffB); PG8_STAGE(PG8_SA(1, 0), cA + kstep, voffA); PG8_STAGE(PG8_SB(1, 1), cB + hstep + kstep, voffB);
        PG8_WAIT_V(6); PG8_BAR;
    }
    for (;;) {
        const bool has_next = S.next(ui + 1, nxt);
        const char* nA = has_next ? (const char*)g.A + (size_t)nxt.pm * tstep : cA; const char* nB = has_next ? (const char*)g.Bt + (size_t)nxt.pn * tstep : cB;
        for (int t = 0; t < nt; t += 2) {
            const bool last = (t == nt - 2);
            const char* a1 = cA + (size_t)(t + 1) * kstep;
            const char* a2 = last ? nA : cA + (size_t)(t + 2) * kstep; const char* b2 = last ? nB : cB + (size_t)(t + 2) * kstep;
            const char* a3 = a2 + kstep; const char* b3 = b2 + kstep;
            if (last && has_next) S.a_ready(nxt);
            if constexpr (SP2) {
            PG8_LDB(B0, 0, 0); PG8_LDB(B1, 0, 1); PG8_SCHED; PG8_LDA(At, 0, 0); PG8_STAGE(PG8_SA(1, 1), a1 + hstep, voffA);
            PG8_WAIT_V(8); PG8_WAIT_L(0); PG8_BAR; PG8_MMA(0, 0, At, B0); PG8_MMA(0, 1, At, B1); PG8_BAR; PG8_SCHED;
            PG8_LDA(At, 0, 1); PG8_STAGE(PG8_SB(0, 0), b2, voffB); PG8_STAGE(PG8_SB(0, 1), b2 + hstep, voffB); PG8_STAGE(PG8_SA(0, 0), a2, voffA);
            PG8_WAIT_V(8); PG8_WAIT_L(0); PG8_BAR; PG8_MMA(1, 0, At, B0); PG8_MMA(1, 1, At, B1); PG8_BAR; PG8_SCHED;
            PG8_LDB(B0, 1, 0); PG8_LDB(B1, 1, 1); PG8_SCHED; PG8_LDA(At, 1, 0); PG8_STAGE(PG8_SA(0, 1), a2 + hstep, voffA);
            PG8_WAIT_V(8); PG8_WAIT_L(0); PG8_BAR; PG8_MMA(0, 0, At, B0); PG8_MMA(0, 1, At, B1); PG8_BAR; PG8_SCHED;
            PG8_LDA(At, 1, 1); PG8_STAGE(PG8_SB(1, 0), b3, voffB); PG8_STAGE(PG8_SB(1, 1), b3 + hstep, voffB); PG8_STAGE(PG8_SA(1, 0), a3, voffA);
            PG8_WAIT_V(8); PG8_WAIT_L(0); PG8_BAR; PG8_MMA(1, 0, At, B0); PG8_MMA(1, 1, At, B1); PG8_BAR; PG8_SCHED;
            } else {
            PG8_LDB(B0, 0, 0); PG8_SCHED; PG8_LDA(At, 0, 0); PG8_STAGE(PG8_SA(1, 1), a1 + hstep, voffA);
            PG8_WAIT_L(8); PG8_BAR; PG8_WAIT_L(0); PG8_MMA(0, 0, At, B0); PG8_BAR; PG8_SCHED;
            PG8_LDB(B1, 0, 1); PG8_STAGE(PG8_SB(0, 0), b2, voffB);
            PG8_BAR; PG8_WAIT_L(0); PG8_MMA(0, 1, At, B1); PG8_BAR;
            PG8_LDA(At, 0, 1); PG8_STAGE(PG8_SA(0, 0), a2, voffA);
            PG8_BAR; PG8_WAIT_L(0); PG8_MMA(1, 0, At, B0); PG8_BAR; PG8_SCHED;
            PG8_STAGE(PG8_SB(0, 1), b2 + hstep, voffB);
            PG8_WAIT_V(6); PG8_BAR; PG8_MMA(1, 1, At, B1); PG8_BAR;
            PG8_LDB(B0, 1, 0); PG8_SCHED; PG8_LDA(At, 1, 0); PG8_STAGE(PG8_SA(0, 1), a2 + hstep, voffA);
            PG8_WAIT_L(8); PG8_BAR; PG8_WAIT_L(0); PG8_MMA(0, 0, At, B0); PG8_BAR; PG8_SCHED;
            PG8_LDB(B1, 1, 1); PG8_STAGE(PG8_SB(1, 0), b3, voffB);
            PG8_BAR; PG8_WAIT_L(0); PG8_MMA(0, 1, At, B1); PG8_BAR;
            PG8_LDA(At, 1, 1); PG8_STAGE(PG8_SA(1, 0), a3, voffA);
            PG8_BAR; PG8_WAIT_L(0); PG8_MMA(1, 0, At, B0); PG8_BAR; PG8_SCHED;
            PG8_STAGE(PG8_SB(1, 1), b3 + hstep, voffB);
            PG8_WAIT_V(6); PG8_BAR; PG8_MMA(1, 1, At, B1); PG8_BAR;
            }
        }
        if constexpr (ALIGN_EPI) { if (wr == 0) PG8_BAR; }
        E(acc, cur, wr, wc, fr, fq); S.done(cur);
        if (!has_next) break;
#pragma unroll
        for (int a = 0; a < 2; ++a)
#pragma unroll
            for (int b = 0; b < 2; ++b)
#pragma unroll
                for (int m = 0; m < 4; ++m)
#pragma unroll
                    for (int n = 0; n < 2; ++n) acc[a][b][m][n] = (f32x4){0.f, 0.f, 0.f, 0.f};
        cur = nxt; cA = nA; cB = nB; ++ui;
        if constexpr (ALIGN_EPI) { if (wr == 1) PG8_BAR; }
    }
    PG8_WAIT_V(0);
    if constexpr (!ALIGN_EPI) { if (wr == 0) PG8_BAR; }
    PG8_BAR;
#undef PG8_SA
#undef PG8_SB
#undef PG8_STAGE
#undef PG8_LDA
#undef PG8_LDB
#undef PG8_MMA
#undef PG8_WAIT_V
#undef PG8_WAIT_L
#undef PG8_BAR
#undef PG8_SCHED
}

struct EpiUp { static constexpr bool PERM = true; bf16_t* O;
    __device__ __forceinline__ void operator()(const f32x4 (&acc)[2][2][4][2], const Unit& u, int wr, int wc, int fr, int fq) const {
        const int row0 = u.pm * BM + wr * 64 + fr, col0 = u.pn * 128 + wc * 32 + 8 * fq;
#pragma unroll
        for (int ai = 0; ai < 2; ++ai)
#pragma unroll
            for (int m = 0; m < 4; ++m) { bf16_t* rowp = O + (size_t)(row0 + ai * HALF + m * 16) * DFF + col0;
                const f32x4 g0 = acc[ai][0][m][0], g1 = acc[ai][0][m][1], u0 = acc[ai][1][m][0], u1 = acc[ai][1][m][1];
                u32x4 w; w.x = cvt_pk_bf16(silu_f(g0[0]) * u0[0], silu_f(g0[1]) * u0[1]); w.y = cvt_pk_bf16(silu_f(g0[2]) * u0[2], silu_f(g0[3]) * u0[3]);
                w.z = cvt_pk_bf16(silu_f(g1[0]) * u1[0], silu_f(g1[1]) * u1[1]); w.w = cvt_pk_bf16(silu_f(g1[2]) * u1[2], silu_f(g1[3]) * u1[3]);
                *(u32x4*)rowp = w; }
    }
};
struct EpiRes { static constexpr bool PERM = false; float* X; const float* gate; float gs;
    __device__ __forceinline__ void operator()(const f32x4 (&acc)[2][2][4][2], const Unit& u, int wr, int wc, int fr, int fq) const {
        const int row0 = u.pm * BM + wr * 64 + fr, col0 = u.pn * BM + wc * 32 + 4 * fq;
        const int b = u.pm < 16 ? 0 : (u.pm < 32 ? 1 : 2);
        f32x4 gv[2][2];
#pragma unroll
        for (int bj = 0; bj < 2; ++bj)
#pragma unroll
            for (int n = 0; n < 2; ++n) gv[bj][n] = *(const f32x4*)(gate + (size_t)b * NMODV + col0 + bj * HALF + n * 16) * gs;
#pragma unroll
        for (int ai = 0; ai < 2; ++ai)
#pragma unroll
            for (int m = 0; m < 4; ++m) { float* rowp = X + (size_t)(row0 + ai * HALF + m * 16) * D + col0;
#pragma unroll
                for (int bj = 0; bj < 2; ++bj)
#pragma unroll
                    for (int n = 0; n < 2; ++n) { f32x4* p = (f32x4*)(rowp + bj * HALF + n * 16); *p = *p + gv[bj][n] * acc[ai][bj][m][n]; } }
    }
};
__device__ __forceinline__ void store8(bf16_t* p, const f32x4 a, const f32x4 b) { u32x4 w; w.x = cvt_pk_bf16(a[0], a[1]); w.y = cvt_pk_bf16(a[2], a[3]); w.z = cvt_pk_bf16(b[0], b[1]); w.w = cvt_pk_bf16(b[2], b[3]); *(u32x4*)p = w; }
struct EpiInEven { static constexpr bool PERM = true; bf16_t* P0; float* DT; const float* cosT; const float* sinT; const float* dtb;
    __device__ __forceinline__ void operator()(const f32x4 (&acc)[2][2][4][2], const Unit& u, int wr, int wc, int fr, int fq) const {
        const int pn = u.pn, row0 = u.pm * BM + wr * 64 + fr;
        const int ti = pn < 20 ? (pn >> 2) : 5; bf16_t* base = P0 + (size_t)ti * ((size_t)MTOT * 1024);
        if (pn < 8) {
            const float sc = pn < 4 ? 1.0f : 0.08838834764831845f;
            const int cb = (pn & 3) * 256 + wc * 32 + 8 * fq, jp = 16 * wc + 4 * fq;
#pragma unroll
            for (int ai = 0; ai < 2; ++ai)
#pragma unroll
                for (int m = 0; m < 4; ++m) { const int row = row0 + ai * HALF + m * 16; const int tr = row < MLAT ? (row & 4095) : 4096 + ((row - MLAT) & 255);
                    const f32x4 cs = *(const f32x4*)(cosT + tr * 64 + jp) * sc, sn = *(const f32x4*)(sinT + tr * 64 + jp) * sc;
#pragma unroll
                    for (int bj = 0; bj < 2; ++bj) { const f32x4 x1 = acc[ai][bj][m][0], x2 = acc[ai][bj][m][1];
                        store8(base + (size_t)row * 1024 + cb + bj * HALF, x1 * cs - x2 * sn, x1 * sn + x2 * cs); } }
        } else if (pn < 26) {
            const int pitch = pn < 20 ? 1024 : XBCW; const int c0 = (pn < 20 ? (pn & 3) : (pn - 20)) * 256 + wc * 32 + 8 * fq;
#pragma unroll
            for (int ai = 0; ai < 2; ++ai)
#pragma unroll
                for (int m = 0; m < 4; ++m) { bf16_t* rowp = base + (size_t)(row0 + ai * HALF + m * 16) * pitch + c0;
#pragma unroll
                    for (int bj = 0; bj < 2; ++bj) store8(rowp + bj * HALF, acc[ai][bj][m][0], acc[ai][bj][m][1]); }
        } else if (wc == 0) {
#pragma unroll
            for (int ai = 0; ai < 2; ++ai)
#pragma unroll
                for (int m = 0; m < 4; ++m) { const int row = row0 + ai * HALF + m * 16;
#pragma unroll
                    for (int n = 0; n < 2; ++n) { const int col = 8 * fq + 4 * n; f32x4 v = acc[ai][0][m][n] + *(const f32x4*)(dtb + col);
#pragma unroll
                        for (int j = 0; j < 4; ++j) v[j] = v[j] > 20.f ? v[j] : log1pf(expf(v[j]));
                        *(f32x4*)(DT + (size_t)row * 32 + col) = v; } }
        }
    }
};
struct EpiInOdd { static constexpr bool PERM = true; bf16_t *BG, *T;
    __device__ __forceinline__ void operator()(const f32x4 (&acc)[2][2][4][2], const Unit& u, int wr, int wc, int fr, int fq) const {
        const int pn = u.pn, row0 = u.pm * BM + wr * 64 + fr;
        if (pn < 8) { const int c0 = pn * 256 + wc * 32 + 8 * fq;
#pragma unroll
            for (int ai = 0; ai < 2; ++ai)
#pragma unroll
                for (int m = 0; m < 4; ++m) { bf16_t* rowp = BG + (size_t)(row0 + ai * HALF + m * 16) * D + c0;
#pragma unroll
                    for (int bj = 0; bj < 2; ++bj) store8(rowp + bj * HALF, acc[ai][bj][m][0], acc[ai][bj][m][1]); }
        } else { const int c0 = (pn - 8) * 128 + wc * 32 + 8 * fq;
#pragma unroll
            for (int ai = 0; ai < 2; ++ai)
#pragma unroll
                for (int m = 0; m < 4; ++m) store8(T + (size_t)(row0 + ai * HALF + m * 16) * D + c0, acc[ai][0][m][0] * acc[ai][1][m][0], acc[ai][0][m][1] * acc[ai][1][m][1]);
        }
    }
};
}

#define XB_TMO      128
#define XB_XCNT(j)  (256  + 64 * (j))
#define XB_XSUB(j)  (1280 + 64 * (j))
#define XB_XGEN(j)  (2304 + 64 * (j))
#define XB_TOP      3328
#define XB_TOPGEN   3392
#define XCD_BAR_WORDS 3456
#define XB_SPIN_CAP (1u << 18)
__device__ __forceinline__ unsigned xb_ld(unsigned* p)              { return __hip_atomic_load(p, __ATOMIC_RELAXED, __HIP_MEMORY_SCOPE_AGENT); }
__device__ __forceinline__ unsigned xb_add(unsigned* p, unsigned v) { return __hip_atomic_fetch_add(p, v, __ATOMIC_RELAXED, __HIP_MEMORY_SCOPE_AGENT); }
__device__ __forceinline__ unsigned xb_xcc_id() { return (unsigned)__builtin_amdgcn_s_getreg((3 << 11) | 20) & 0xFu; }
#define XB_SPIN(cond, bar) do { unsigned _sp = 0; while (cond) { __builtin_amdgcn_s_sleep(1); \
    if ((++_sp & 255u) == 0u) { if (xb_ld(&(bar)[XB_TMO])) break; if (_sp > XB_SPIN_CAP) { atomicAdd(&(bar)[XB_TMO], 1u); break; } } } } while (0)
struct XcdBarrier { unsigned* bar; unsigned x; volatile LAS unsigned* st; };
__device__ __forceinline__ XcdBarrier xcd_barrier_post(unsigned* bar, volatile LAS unsigned* st) {
    XcdBarrier b; b.bar = bar; b.x = xb_xcc_id(); b.st = st;
    if (threadIdx.x == 0) (void)xb_add(&bar[XB_XCNT(b.x)], 1u);
    return b;
}
__device__ __forceinline__ void xcd_barrier_complete(unsigned* bar, unsigned x, unsigned& nloc, unsigned& nx) {
    const unsigned G = gridDim.x * gridDim.y * gridDim.z;
    unsigned sum, cnt, mine, sp = 0u;
    for (;;) {
        sum = 0u; cnt = 0u; mine = 0u;
#pragma unroll
        for (unsigned j = 0; j < 16; ++j) { const unsigned c = xb_ld(&bar[XB_XCNT(j)]); sum += c; cnt += (c > 0u) ? 1u : 0u; mine = (j == x) ? c : mine; }
        if (sum == G) break;
        __builtin_amdgcn_s_sleep(1);
        if ((++sp & 255u) == 0u) { if (xb_ld(&bar[XB_TMO])) break; if (sp > XB_SPIN_CAP) { atomicAdd(&bar[XB_TMO], 1u); break; } }
    }
    nloc = mine > 0u ? mine : 1u; nx = cnt > 0u ? cnt : 1u;
}
__device__ __forceinline__ void xcd_barrier(const XcdBarrier& b) {
    asm volatile("s_waitcnt vmcnt(0)" ::: "memory");
    __syncthreads();
    if (threadIdx.x == 0) {
        unsigned* bar = b.bar;
        __builtin_amdgcn_s_waitcnt(0);
        unsigned nloc = b.st[0], nx = b.st[1];
        if (nloc == 0u) { xcd_barrier_complete(bar, b.x, nloc, nx); b.st[0] = nloc; b.st[1] = nx; }
        const unsigned old = xb_add(&bar[XB_XSUB(b.x)], 1u);
        const unsigned gen = old / nloc;
        if (old + 1u == (gen + 1u) * nloc) {
            __builtin_amdgcn_fence(__ATOMIC_RELEASE, "agent");
            asm volatile("s_waitcnt vmcnt(0)" ::: "memory");
            const unsigned og = xb_add(&bar[XB_TOP], 1u);
            const unsigned tg = og / nx;
            if (og + 1u == (tg + 1u) * nx) xb_add(&bar[XB_TOPGEN], 1u);
            else XB_SPIN(xb_ld(&bar[XB_TOPGEN]) == tg, bar);
            __builtin_amdgcn_fence(__ATOMIC_ACQUIRE, "agent");
            xb_add(&bar[XB_XGEN(b.x)], 1u);
            asm volatile("s_waitcnt vmcnt(0)" ::: "memory");
        } else {
            XB_SPIN(xb_ld(&bar[XB_XGEN(b.x)]) == gen, bar);
            __builtin_amdgcn_fence(__ATOMIC_ACQUIRE, "agent");
            asm volatile("s_waitcnt vmcnt(0)" ::: "memory");
        }
    }
    __syncthreads();
}

struct Args { const float* in[23]; float* out; unsigned char* ws; int ph_lo, ph_hi; };
enum { I_X = 0, I_C, I_CTX, I_CCTX, I_ADAW, I_ADAB, I_NORMG, I_FINALG, I_FUP, I_FDN, I_MWIN, I_MCW, I_MCB, I_RLD, I_RGN, I_SALOG, I_SDTB, I_SD, I_SNG, I_MWOUT, I_SCWIN, I_SCCW, I_SCWOUT };
struct Frame { LAS unsigned char* lds; unsigned char* ws; int tid, lane, wave, vcu, G; };
#define LDS_WAIT() asm volatile("s_waitcnt lgkmcnt(0)" ::: "memory")
__device__ __forceinline__ Frame mk_frame(unsigned char* ws_in, LAS unsigned char* lds_in, int G, int vcu) {
    Frame F; int t = threadIdx.x; asm volatile("" : "+v"(t)); F.tid = t; F.lane = t & 63; F.wave = __builtin_amdgcn_readfirstlane(t >> 6);
    unsigned long long w = (unsigned long long)ws_in; asm volatile("" : "+s"(w)); F.ws = (unsigned char*)w;
    unsigned lb = 0; asm volatile("" : "+s"(lb)); F.lds = lds_in + lb; F.G = G; F.vcu = vcu; return F; }

__device__ __forceinline__ float wave_sum(float v) {
#pragma unroll
    for (int o = 1; o < 64; o <<= 1) v += __shfl_xor(v, o);
    return v;
}

__device__ __forceinline__ int dest_row(int mode, int n) {
    if (mode == 1) { const int half = n >= DFF ? 1 : 0, j = n - half * DFF; return 256 * (j >> 7) + 128 * half + (j & 127); }
    if (mode == 2) { if (n >= 2048) return n; const int hd = n >> 7, j = n & 127, hb = j >> 6, jj = j & 63; return hd * 128 + 32 * (jj >> 4) + 8 * ((jj >> 2) & 3) + 4 * hb + (jj & 3); }
    if (mode == 3) { if (n < 2048) return n; if (n < 4096) { const int j = n - 2048; return 2048 + 256 * (j >> 7) + (j & 127); } const int j = n - 4096; return 2048 + 256 * (j >> 7) + 128 + (j & 127); }
    return n;
}
__device__ __forceinline__ void xpose_item(const float* W, int K, int N, bf16_t* WT, int mode, LAS float* scr, int item, int lane) {
    const int nnb = (N + 63) >> 6, kb = item / nnb, nb = item - kb * nnb, k0 = 64 * kb, n0 = 64 * nb;
    const int c4 = (lane & 15) * 4; const bool cok = (n0 + c4) < N;
    f32x4 v[16];
#pragma unroll
    for (int i = 0; i < 16; ++i) { const int kk = 4 * i + (lane >> 4); v[i] = cok ? *(const f32x4*)(W + (size_t)(k0 + kk) * N + n0 + c4) : (f32x4){0.f, 0.f, 0.f, 0.f}; }
#pragma unroll
    for (int i = 0; i < 16; ++i) { const int kk = 4 * i + (lane >> 4); LAS float* s = scr + kk * 65 + c4; s[0] = v[i][0]; s[1] = v[i][1]; s[2] = v[i][2]; s[3] = v[i][3]; }
    LDS_WAIT(); asm volatile("" ::: "memory");
    const int nl = lane >> 3, c = lane & 7;
#pragma unroll
    for (int j = 0; j < 8; ++j) { const int n = 8 * j + nl; const LAS float* s = scr + (8 * c) * 65 + n;
        u32x4 o; o.x = cvt_pk_bf16(s[0], s[65]); o.y = cvt_pk_bf16(s[2 * 65], s[3 * 65]); o.z = cvt_pk_bf16(s[4 * 65], s[5 * 65]); o.w = cvt_pk_bf16(s[6 * 65], s[7 * 65]);
        if (n0 + n < N) *(u32x4*)(WT + (size_t)dest_row(mode, n0 + n) * K + k0 + 8 * c) = o; }
    LDS_WAIT(); asm volatile("" ::: "memory");
}
__device__ __forceinline__ void prologue(const Frame& F, const Args& a) {
    LAS float* scr = (LAS float*)(F.lds + F.wave * 16640);
    const int gw = F.vcu * 8 + F.wave, NGW = F.G * 8, lane = F.lane;
    unsigned char* ws = F.ws;
    for (int it = gw; it < 4 * 16 * 72; it += NGW) {
        const int l = it / (16 * 72), r = it - l * (16 * 72), ks = r / 72, cg = r - ks * 72, k0 = ks * 128, n0 = cg * 256 + 4 * lane;
        LAS float* sl = scr;
#pragma unroll
        for (int w = 0; w < 3; ++w)
#pragma unroll
            for (int hh = 0; hh < 2; ++hh) { const int k = k0 + hh * 64 + lane; const float cv = w < 2 ? a.in[I_C][w * D + k] : a.in[I_CCTX][k]; sl[w * 128 + hh * 64 + lane] = cv / (1.0f + expf(-cv)); }
        LDS_WAIT(); asm volatile("" ::: "memory");
        const float* Wp = a.in[I_ADAW] + ((size_t)l * D + k0) * NMODV + n0;
        f32x4 a0 = {0.f, 0.f, 0.f, 0.f}, a1 = a0, a2 = a0;
#pragma unroll 8
        for (int kk = 0; kk < 128; ++kk) { const f32x4 w = *(const f32x4*)(Wp + (size_t)kk * NMODV); a0 += w * sl[kk]; a1 += w * sl[128 + kk]; a2 += w * sl[256 + kk]; }
        float* po = (float*)(ws + WS_PART) + ((size_t)(ks * 4 + l) * 3) * NMODV + n0;
        *(f32x4*)po = a0; *(f32x4*)(po + NMODV) = a1; *(f32x4*)(po + 2 * NMODV) = a2;
        LDS_WAIT(); asm volatile("" ::: "memory");
    }
    constexpr int I_UP = 32 * 176, I_DN = 88 * 32, I_MI = 32 * 105, I_SQ = 32 * 32, I_SI = 32 * 96;
    constexpr int B0 = 8 * I_UP, B1 = B0 + 8 * I_DN, B2 = B1 + 2 * I_MI, B3 = B2 + 2 * I_SQ, B4 = B3 + 2 * I_SI, B5 = B4 + 2 * I_SQ;
    for (int it = gw; it < B5; it += NGW) {
        if (it < B0) { const int mi = it / I_UP; xpose_item(a.in[I_FUP] + (size_t)mi * D * 2 * DFF, D, 2 * DFF, (bf16_t*)(ws + WS_WUP + mi * SZ_WUP), 1, scr, it - mi * I_UP, lane); }
        else if (it < B1) { const int r = it - B0, mi = r / I_DN; xpose_item(a.in[I_FDN] + (size_t)mi * DFF * D, DFF, D, (bf16_t*)(ws + WS_WDN + mi * SZ_WDN), 0, scr, r - mi * I_DN, lane); }
        else if (it < B2) { const int r = it - B1, mi = r / I_MI; xpose_item(a.in[I_MWIN] + (size_t)mi * D * INW, D, INW, (bf16_t*)(ws + WS_WMI + mi * SZ_WMI), 2, scr, r - mi * I_MI, lane); }
        else if (it < B3) { const int r = it - B2, mi = r / I_SQ; xpose_item(a.in[I_MWOUT] + (size_t)mi * D * D, D, D, (bf16_t*)(ws + WS_WMO + mi * SZ_WSQ), 0, scr, r - mi * I_SQ, lane); }
        else if (it < B4) { const int r = it - B3, mi = r / I_SI; xpose_item(a.in[I_SCWIN] + (size_t)mi * D * 3 * D, D, 3 * D, (bf16_t*)(ws + WS_WSI + mi * SZ_WSI), 3, scr, r - mi * I_SI, lane); }
        else { const int r = it - B4, mi = r / I_SQ; xpose_item(a.in[I_SCWOUT] + (size_t)mi * D * D, D, D, (bf16_t*)(ws + WS_WSO + mi * SZ_WSQ), 0, scr, r - mi * I_SQ, lane); }
    }
    const int gt = F.vcu * 512 + F.tid, NT = F.G * 512;
    for (int i = gt; i < MTOT * (D / 4); i += NT) { const int row = i >> 9, c = (i & 511) * 4;
        const float* src = row < MLAT ? a.in[I_X] + (size_t)row * D + c : a.in[I_CTX] + (size_t)(row - MLAT) * D + c;
        *(f32x4*)((float*)(ws + WS_X) + (size_t)row * D + c) = *(const f32x4*)src; }
    for (int i = gt; i < 4352 * 64; i += NT) { const int r = i >> 6, j = i & 63;
        float p0, p1, p2; if (r < 4096) { p0 = 256.f; p1 = (float)(r >> 6); p2 = (float)(r & 63); } else { p0 = (float)(r - 4096); p1 = 0.f; p2 = 0.f; }
        float ang; if (j < 16) ang = p0 * powf(10000.f, -(float)j / 16.f); else if (j < 40) ang = p1 * powf(10000.f, -(float)(j - 16) / 24.f); else ang = p2 * powf(10000.f, -(float)(j - 40) / 24.f);
        ((float*)(ws + WS_ROPE))[i] = cosf(ang); ((float*)(ws + WS_ROPE))[4352 * 64 + i] = sinf(ang); }
}

__device__ __forceinline__ void modreduce_phase(const Frame& F, const Args& a) {
    const int gt = F.vcu * 512 + F.tid, NT = F.G * 512;
    for (int i = gt; i < 12 * NMODV / 4; i += NT) { const int e = i * 4, l = e / (3 * NMODV), n = e % NMODV;
        f32x4 acc = *(const f32x4*)(a.in[I_ADAB] + (size_t)l * NMODV + n);
#pragma unroll
        for (int ks = 0; ks < 16; ++ks) acc += *(const f32x4*)((const float*)(F.ws + WS_PART) + (size_t)ks * 12 * NMODV + e);
        *(f32x4*)((float*)(F.ws + WS_MOD) + e) = acc; }
}
__device__ __forceinline__ void norm_phase(const Frame& F, const Args& a, int l, int idx, int M) {
    const int gw = F.vcu * 8 + F.wave, NGW = F.G * 8, lane = F.lane;
    const float* gp = a.in[I_NORMG] + (size_t)(l * 3 + idx) * D;
    for (int row = gw; row < M; row += NGW) {
        const int b = row < SEQ ? 0 : (row < MLAT ? 1 : 2);
        const float* mod = (const float*)(F.ws + WS_MOD) + (size_t)((l * 3 + b) * 9 + 3 * idx) * D;
        const f32x4* xr = (const f32x4*)((const float*)(F.ws + WS_X) + (size_t)row * D) + lane;
        f32x4 v[8]; float s = 0.f;
#pragma unroll
        for (int j = 0; j < 8; ++j) { v[j] = xr[64 * j]; s += (v[j][0] * v[j][0] + v[j][1] * v[j][1]) + (v[j][2] * v[j][2] + v[j][3] * v[j][3]); }
        const float rstd = 1.0f / sqrtf(wave_sum(s) * (1.0f / D) + EPS);
        u32x2* o = (u32x2*)((bf16_t*)(F.ws + WS_H) + (size_t)row * D) + lane;
#pragma unroll
        for (int j = 0; j < 8; ++j) { const int c = 4 * lane + 256 * j; const f32x4 g = *(const f32x4*)(gp + c), sh = *(const f32x4*)(mod + c), sc = *(const f32x4*)(mod + D + c);
            const f32x4 y = v[j] * rstd * g * (sc + 1.0f) + sh; u32x2 w; w.x = cvt_pk_bf16(y[0], y[1]); w.y = cvt_pk_bf16(y[2], y[3]); o[64 * j] = w; }
    }
}
__device__ __forceinline__ void final_phase(const Frame& F, const Args& a) {
    const int gw = F.vcu * 8 + F.wave, NGW = F.G * 8, lane = F.lane;
    const float* gp = a.in[I_FINALG];
    for (int row = gw; row < MLAT; row += NGW) {
        const f32x4* xr = (const f32x4*)((const float*)(F.ws + WS_X) + (size_t)row * D) + lane;
        f32x4 v[8]; float s = 0.f;
#pragma unroll
        for (int j = 0; j < 8; ++j) { v[j] = xr[64 * j]; s += (v[j][0] * v[j][0] + v[j][1] * v[j][1]) + (v[j][2] * v[j][2] + v[j][3] * v[j][3]); }
        const float rstd = 1.0f / sqrtf(wave_sum(s) * (1.0f / D) + EPS);
        f32x4* o = (f32x4*)(a.out + (size_t)row * D) + lane;
#pragma unroll
        for (int j = 0; j < 8; ++j) { const f32x4 g = *(const f32x4*)(gp + 4 * lane + 256 * j); o[64 * j] = v[j] * rstd * g; }
    }
}
__device__ __forceinline__ void dbg_dump(const Frame& F, const Args& a, size_t off, size_t nbytes) {
    const int gt = F.vcu * 512 + F.tid, NT = F.G * 512; const size_t n = nbytes / 2; const unsigned short* p = (const unsigned short*)(F.ws + off);
    for (int i = gt; i < MLAT * D; i += NT) { float s = 0.f; for (size_t j = i; j < n; j += (size_t)MLAT * D) s += (float)p[j]; a.out[i] = s; }
}
__device__ __forceinline__ void row_nbrs(int row, bool& hasL, bool& hasR) {
    if (row < MLAT) { const int t = row & 63; hasL = t > 0; hasR = t < 63; } else { const int t = (row - MLAT) & 255; hasL = t > 0; hasR = t < 255; }
}
__device__ __forceinline__ void scconv_phase(const Frame& F, const Args& a, int m, int M) {
    const int gt = F.vcu * 512 + F.tid, NT = F.G * 512;
    const bf16_t* BG = (const bf16_t*)(F.ws + WS_BG); const bf16_t* T = (const bf16_t*)(F.ws + WS_T); bf16_t* O = (bf16_t*)(F.ws + WS_MRG);
    const float* cw = a.in[I_SCCW] + (size_t)m * 3 * D;
    for (int it = gt; it < M * 256; it += NT) { const int row = it >> 8, c0 = (it & 255) * 8; bool hl, hr; row_nbrs(row, hl, hr);
        const size_t off = (size_t)row * D + c0; const u32x4 z4 = {0u, 0u, 0u, 0u};
        const u32x4 tc = *(const u32x4*)(T + off), tl = hl ? *(const u32x4*)(T + off - D) : z4, tr = hr ? *(const u32x4*)(T + off + D) : z4, bg = *(const u32x4*)(BG + off);
        float fc[8], fl[8], fr_[8], fb[8], o[8]; unpack8(tc, fc); unpack8(tl, fl); unpack8(tr, fr_); unpack8(bg, fb);
#pragma unroll
        for (int j = 0; j < 8; ++j) o[j] = fb[j] * (cw[c0 + j] * fl[j] + cw[D + c0 + j] * fc[j] + cw[2 * D + c0 + j] * fr_[j]);
        *(u32x4*)(O + off) = pack8(o); }
}
__device__ __forceinline__ void conv8(const bf16_t* XBC, const float* cw, const float* cb, int row, int col, float* o) {
#ifdef DBG_E2
    { const u32x4 xc0 = *(const u32x4*)(XBC + (size_t)row * XBCW + col); unpack8(xc0, o); return; }
#endif
    bool hl, hr; row_nbrs(row, hl, hr); const size_t off = (size_t)row * XBCW + col; const u32x4 z4 = {0u, 0u, 0u, 0u};
    const u32x4 xc = *(const u32x4*)(XBC + off), xl = hl ? *(const u32x4*)(XBC + off - XBCW) : z4, xr = hr ? *(const u32x4*)(XBC + off + XBCW) : z4;
    float fc[8], fl[8], fr_[8]; unpack8(xc, fc); unpack8(xl, fl); unpack8(xr, fr_);
#pragma unroll
    for (int j = 0; j < 8; ++j) o[j] = silu_f(cw[col + j] * fl[j] + cw[XBCW + col + j] * fc[j] + cw[2 * XBCW + col + j] * fr_[j] + cb[col + j]);
}

template <int NK> __device__ __forceinline__ f32x4 tile_mma(const LAS bf16_t* L, int ldl, const LAS bf16_t* R, int ldr, f32x4 acc, int fr, int fq) {
#pragma unroll
    for (int kk = 0; kk < NK; ++kk) { const bf16x8 l = *(const LAS bf16x8*)(L + fr * ldl + kk * 32 + 8 * fq); const bf16x8 r = *(const LAS bf16x8*)(R + fr * ldr + kk * 32 + 8 * fq);
        acc = __builtin_amdgcn_mfma_f32_16x16x32_bf16(r, l, acc, 0, 0, 0); }
    return acc;
}
__device__ __forceinline__ int chunk_row0(int cc, int b) { return cc < 64 ? b * SEQ + cc * 64 : MLAT + b * CTXL + (cc - 64) * 64; }
__device__ __forceinline__ void st4(bf16_t* p, const f32x4 v) { u32x2 w; w.x = cvt_pk_bf16(v[0], v[1]); w.y = cvt_pk_bf16(v[2], v[3]); *(u32x2*)p = w; }
__device__ __forceinline__ void st4l(LAS bf16_t* p, const f32x4 v) { u32x2 w; w.x = cvt_pk_bf16(v[0], v[1]); w.y = cvt_pk_bf16(v[2], v[3]); *(LAS u32x2*)p = w; }

__device__ __forceinline__ void retA_unit(const Frame& F, const Args& a, int m, int cc, int b, int h) {
    LAS bf16_t* Ktf = (LAS bf16_t*)F.lds; LAS bf16_t* Ktb = Ktf + 128 * 72; LAS bf16_t* Vt = Ktb + 128 * 72;
    const int r0 = chunk_row0(cc, b), tid = F.tid, w = F.wave, fr = F.lane & 15, fq = F.lane >> 4;
    const float lgf = a.in[I_RLD][m * 16 + h], lgb = a.in[I_RLD][m * 16 + 8 + h];
    const bf16_t* Kg = (const bf16_t*)(F.ws + WS_K); const bf16_t* Vg = (const bf16_t*)(F.ws + WS_V);
#pragma unroll
    for (int i = 0; i < 2; ++i) { const int idx = tid + i * 512, k = idx >> 4, d0 = (idx & 15) * 8;
        const u32x4 kv = *(const u32x4*)(Kg + (size_t)(r0 + k) * 1024 + h * 128 + d0), vv = *(const u32x4*)(Vg + (size_t)(r0 + k) * 1024 + h * 128 + d0);
        float kf[8], vf[8]; unpack8(kv, kf); unpack8(vv, vf); const float df = fexp(lgf * (float)(63 - k)), db = fexp(lgb * (float)k);
#pragma unroll
        for (int j = 0; j < 8; ++j) { Ktf[(d0 + j) * 72 + k] = f2bf(kf[j] * df); Ktb[(d0 + j) * 72 + k] = f2bf(kf[j] * db); Vt[(d0 + j) * 72 + k] = f2bf(vf[j]); } }
    __syncthreads();
    bf16_t* U = (bf16_t*)(F.ws + WS_RST) + (size_t)(((cc * 2 + b) * 8 + h) * 2) * 16384;
#pragma unroll
    for (int dir = 0; dir < 2; ++dir) { const LAS bf16_t* Kt = dir ? Ktb : Ktf;
#pragma unroll
        for (int dt = 0; dt < 8; ++dt) { f32x4 acc = {0.f, 0.f, 0.f, 0.f}; acc = tile_mma<2>(Vt + 16 * w * 72, 72, Kt + 16 * dt * 72, 72, acc, fr, fq);
            st4(U + (size_t)dir * 16384 + (16 * w + fr) * 128 + 16 * dt + 4 * fq, acc); } }
    __syncthreads();
}
__device__ __forceinline__ void dt_scan(const Frame& F, const Args& a, int m, int r0, int hd, float& dtf, float& dtb, float& cf, float& sb) {
    const float* DT = (const float*)(F.ws + WS_DT); const int lane = F.lane;
    dtf = DT[(size_t)(r0 + lane) * 32 + hd]; dtb = DT[(size_t)(r0 + lane) * 32 + 16 + hd];
    const float af = -expf(a.in[I_SALOG][m * 32 + hd]), ab = -expf(a.in[I_SALOG][m * 32 + 16 + hd]);
    float p = dtf, s = dtb;
#pragma unroll
    for (int o = 1; o < 64; o <<= 1) { const float t = __shfl_up(p, o); if (lane >= o) p += t; const float t2 = __shfl_down(s, o); if (lane + o < 64) s += t2; }
    cf = af * p; sb = ab * s;
}
__device__ __forceinline__ void ssdA_unit(const Frame& F, const Args& a, int m, int cc, int b, int hd) {
    LAS bf16_t* Bt = (LAS bf16_t*)F.lds; LAS bf16_t* xtf = Bt + 128 * 72; LAS bf16_t* xtb = xtf + 64 * 72; LAS float* tef = (LAS float*)(xtb + 64 * 72); LAS float* teb = tef + 64;
    const int r0 = chunk_row0(cc, b), tid = F.tid, w = F.wave, lane = F.lane, fr = lane & 15, fq = lane >> 4, grp = hd >> 3;
    if (w == 0) { float dtf, dtb, cf, sb; dt_scan(F, a, m, r0, hd, dtf, dtb, cf, sb);
        const float cf63 = __shfl(cf, 63), sb0 = __shfl(sb, 0);
#ifdef DBG_E1
        tef[lane] = 1.0f; teb[lane] = 0.5f;
#else
        tef[lane] = fexp(cf63 - cf) * dtf; teb[lane] = fexp(sb0 - sb) * dtb;
#endif
        if (lane == 0) { float* cd = (float*)(F.ws + WS_CHDEC) + (size_t)((cc * 2 + b) * 2) * 16 + hd; cd[0] = fexp(cf63); cd[16] = fexp(sb0); } }
    __syncthreads();
    const bf16_t* XBC = (const bf16_t*)(F.ws + WS_XBC); const float* cw = a.in[I_MCW] + (size_t)m * 3 * XBCW; const float* cbp = a.in[I_MCB] + (size_t)m * XBCW;
#pragma unroll
    for (int i = 0; i < 2; ++i) { const int idx = tid + i * 512, k = idx >> 4, n0 = (idx & 15) * 8; float v[8]; conv8(XBC, cw, cbp, r0 + k, 1024 + grp * 128 + n0, v);
#pragma unroll
        for (int j = 0; j < 8; ++j) Bt[(n0 + j) * 72 + k] = f2bf(v[j]); }
    { const int k = tid >> 3, p0 = (tid & 7) * 8; float v[8]; conv8(XBC, cw, cbp, r0 + k, hd * 64 + p0, v); const float tf = tef[k], tb = teb[k];
#pragma unroll
        for (int j = 0; j < 8; ++j) { xtf[(p0 + j) * 72 + k] = f2bf(v[j] * tf); xtb[(p0 + j) * 72 + k] = f2bf(v[j] * tb); } }
    __syncthreads();
    bf16_t* U = (bf16_t*)(F.ws + WS_SST) + (size_t)(((cc * 2 + b) * 16 + hd) * 2) * 8192;
    const int tp = w >> 1;
#pragma unroll
    for (int dir = 0; dir < 2; ++dir) { const LAS bf16_t* xt = dir ? xtb : xtf;
#pragma unroll
        for (int t = 0; t < 4; ++t) { const int tn = (w & 1) * 4 + t; f32x4 acc = {0.f, 0.f, 0.f, 0.f}; acc = tile_mma<2>(xt + 16 * tp * 72, 72, Bt + 16 * tn * 72, 72, acc, fr, fq);
            st4(U + (size_t)dir * 8192 + (16 * tp + fr) * 128 + 16 * tn + 4 * fq, acc); } }
    __syncthreads();
}
__device__ __forceinline__ void scanA_phase(const Frame& F, const Args& a, int m) {
    for (int u = F.vcu; u < 68 * 16; u += F.G) retA_unit(F, a, m, u >> 4, (u >> 3) & 1, u & 7);
    for (int u = F.vcu; u < 68 * 32; u += F.G) ssdA_unit(F, a, m, u >> 5, (u >> 4) & 1, u & 15);
}
__device__ __forceinline__ void scanB_phase(const Frame& F, const Args& a, int m) {
    const int gt = F.vcu * 512 + F.tid, NT = F.G * 512;
    for (int g = gt; g < 131072; g += NT) {
        const bool isret = g < 65536; const int e = (isret ? g : g - 65536) * 8;
        bf16_t* base; float decc = 0.f; const float* chd = nullptr; int dir;
        if (isret) { const int idx = e >> 14; dir = idx & 1; const int h = (idx >> 1) & 7; decc = fexp(64.f * a.in[I_RLD][m * 16 + dir * 8 + h]); base = (bf16_t*)(F.ws + WS_RST) + e; }
        else { const int idx = e >> 13; dir = idx & 1; const int hd = (idx >> 1) & 15, b = idx >> 5; base = (bf16_t*)(F.ws + WS_SST) + e; chd = (const float*)(F.ws + WS_CHDEC) + (b * 2 + dir) * 16 + hd; }
        float car[8];
#pragma unroll
        for (int j = 0; j < 8; ++j) car[j] = 0.f;
#pragma nounroll
        for (int s0 = 0; s0 < 68; s0 += 4) {
            u32x4 uv[4]; float dc[4]; int ccs[4];
#pragma unroll
            for (int q = 0; q < 4; ++q) { const int s = s0 + q; ccs[q] = dir ? 67 - s : (s < 4 ? 64 + s : s - 4); uv[q] = *(const u32x4*)(base + (size_t)ccs[q] * 524288); dc[q] = isret ? decc : chd[ccs[q] * 64]; }
#pragma unroll
            for (int q = 0; q < 4; ++q) { float uf[8]; unpack8(uv[q], uf); *(u32x4*)(base + (size_t)ccs[q] * 524288) = pack8(car);
#pragma unroll
                for (int j = 0; j < 8; ++j) car[j] = car[j] * dc[q] + uf[j]; }
        }
    }
}
__device__ __forceinline__ void retC_unit(const Frame& F, const Args& a, int m, int cc, int b, int h) {
    LAS bf16_t* Qs = (LAS bf16_t*)F.lds; LAS bf16_t* Ks = Qs + 64 * 136; LAS bf16_t* Vt = Ks + 64 * 136; LAS bf16_t* P = Vt + 128 * 72; LAS bf16_t* Sf = P + 64 * 72; LAS bf16_t* Sb = Sf + 128 * 136;
    LAS float* Ob = (LAS float*)Sf;
    const int r0 = chunk_row0(cc, b), tid = F.tid, w = F.wave, lane = F.lane, fr = lane & 15, fq = lane >> 4;
    const float lgf = a.in[I_RLD][m * 16 + h], lgb = a.in[I_RLD][m * 16 + 8 + h];
    const bf16_t* Qg = (const bf16_t*)(F.ws + WS_Q); const bf16_t* Kg = (const bf16_t*)(F.ws + WS_K); const bf16_t* Vg = (const bf16_t*)(F.ws + WS_V);
    const bf16_t* St = (const bf16_t*)(F.ws + WS_RST) + (size_t)(((cc * 2 + b) * 8 + h) * 2) * 16384;
#pragma unroll
    for (int i = 0; i < 2; ++i) { const int idx = tid + i * 512, k = idx >> 4, d0 = (idx & 15) * 8; const size_t go = (size_t)(r0 + k) * 1024 + h * 128 + d0;
        *(LAS u32x4*)(Qs + k * 136 + d0) = *(const u32x4*)(Qg + go); *(LAS u32x4*)(Ks + k * 136 + d0) = *(const u32x4*)(Kg + go);
        const u32x4 vv = *(const u32x4*)(Vg + go); const unsigned short* vs = (const unsigned short*)&vv;
        Vt[(d0 + 0) * 72 + k] = (bf16_t)(vv.x & 0xffffu); Vt[(d0 + 1) * 72 + k] = (bf16_t)(vv.x >> 16); Vt[(d0 + 2) * 72 + k] = (bf16_t)(vv.y & 0xffffu); Vt[(d0 + 3) * 72 + k] = (bf16_t)(vv.y >> 16);
        Vt[(d0 + 4) * 72 + k] = (bf16_t)(vv.z & 0xffffu); Vt[(d0 + 5) * 72 + k] = (bf16_t)(vv.z >> 16); Vt[(d0 + 6) * 72 + k] = (bf16_t)(vv.w & 0xffffu); Vt[(d0 + 7) * 72 + k] = (bf16_t)(vv.w >> 16); (void)vs; }
#pragma unroll
    for (int i = 0; i < 4; ++i) { const int idx = tid + i * 512, v = idx >> 4, d0 = (idx & 15) * 8;
        *(LAS u32x4*)(Sf + v * 136 + d0) = *(const u32x4*)(St + (size_t)v * 128 + d0); *(LAS u32x4*)(Sb + v * 136 + d0) = *(const u32x4*)(St + 16384 + (size_t)v * 128 + d0); }
    __syncthreads();
    const int tq = w >> 1, q = 16 * tq + fr;
#pragma unroll
    for (int t = 0; t < 2; ++t) { const int tk = (w & 1) * 2 + t; f32x4 acc = {0.f, 0.f, 0.f, 0.f}; acc = tile_mma<4>(Qs + 16 * tq * 136, 136, Ks + 16 * tk * 136, 136, acc, fr, fq);
#pragma unroll
        for (int i = 0; i < 4; ++i) { const int k = 16 * tk + 4 * fq + i, d = q - k; const float dcm = (d >= 0 ? fexp(lgf * (float)d) : 0.f) + (d <= 0 ? fexp(lgb * (float)(-d)) : 0.f); acc[i] *= dcm; }
        st4l(P + q * 72 + 16 * tk + 4 * fq, acc); }
    __syncthreads();
    f32x4 o[4]; const float qdf = fexp(lgf * (float)(q + 1)), qdb = fexp(lgb * (float)(64 - q));
#pragma unroll
    for (int t = 0; t < 4; ++t) { const int tv = (w & 1) * 4 + t; const f32x4 z = {0.f, 0.f, 0.f, 0.f};
        const f32x4 aP = tile_mma<2>(P + 16 * tq * 72, 72, Vt + 16 * tv * 72, 72, z, fr, fq);
        const f32x4 aF = tile_mma<4>(Qs + 16 * tq * 136, 136, Sf + 16 * tv * 136, 136, z, fr, fq);
        const f32x4 aB = tile_mma<4>(Qs + 16 * tq * 136, 136, Sb + 16 * tv * 136, 136, z, fr, fq);
        o[t] = aP + aF * qdf + aB * qdb; }
    __syncthreads();
#pragma unroll
    for (int t = 0; t < 4; ++t) { const int tv = (w & 1) * 4 + t; *(LAS f32x4*)(Ob + q * 132 + 16 * tv + 4 * fq) = o[t]; }
    __syncthreads();
    { const int qq = tid >> 3, v0 = (tid & 7) * 16, row = r0 + qq; f32x4 x[4]; float s = 0.f;
#pragma unroll
        for (int j = 0; j < 4; ++j) { x[j] = *(const LAS f32x4*)(Ob + qq * 132 + v0 + 4 * j); s += (x[j][0] + x[j][1]) + (x[j][2] + x[j][3]); }
        s += __shfl_xor(s, 1); s += __shfl_xor(s, 2); s += __shfl_xor(s, 4); const float mean = s * (1.0f / 128.f); float ss = 0.f;
#pragma unroll
        for (int j = 0; j < 4; ++j) { x[j] = x[j] - mean; ss += (x[j][0] * x[j][0] + x[j][1] * x[j][1]) + (x[j][2] * x[j][2] + x[j][3] * x[j][3]); }
        ss += __shfl_xor(ss, 1); ss += __shfl_xor(ss, 2); ss += __shfl_xor(ss, 4); const float rstd = 1.0f / sqrtf(ss * (1.0f / 128.f) + EPS);
        const bf16_t* Gg = (const bf16_t*)(F.ws + WS_G) + (size_t)row * 1024 + h * 128 + v0; const float* gn = a.in[I_RGN] + (size_t)m * 1024 + h * 128 + v0;
        bf16_t* op = (bf16_t*)(F.ws + WS_MRG) + (size_t)row * D + h * 128 + v0;
#pragma unroll
        for (int hf = 0; hf < 2; ++hf) { float gf[8], ov[8]; unpack8(*(const u32x4*)(Gg + 8 * hf), gf);
#pragma unroll
            for (int j = 0; j < 8; ++j) ov[j] = x[2 * hf + (j >> 2)][j & 3] * rstd * gn[8 * hf + j] * silu_f(gf[j]);
            *(u32x4*)(op + 8 * hf) = pack8(ov); } }
    __syncthreads();
}
__device__ __forceinline__ void ssdC_unit(const Frame& F, const Args& a, int m, int cc, int b, int hd) {
    LAS bf16_t* Cs = (LAS bf16_t*)F.lds; LAS bf16_t* Bs = Cs + 64 * 136; LAS bf16_t* xt = Bs + 64 * 136; LAS bf16_t* W = xt + 64 * 72; LAS bf16_t* Sf = W + 64 * 72; LAS bf16_t* Sb = Sf + 64 * 136;
    LAS float* cfa = (LAS float*)(Sb + 64 * 136); LAS float* sba = cfa + 64; LAS float* dfa = sba + 64; LAS float* dba = dfa + 64;
    const int r0 = chunk_row0(cc, b), tid = F.tid, w = F.wave, lane = F.lane, fr = lane & 15, fq = lane >> 4, grp = hd >> 3;
    if (w == 0) { float dtf, dtb, cf, sb; dt_scan(F, a, m, r0, hd, dtf, dtb, cf, sb); cfa[lane] = cf; sba[lane] = sb; dfa[lane] = dtf; dba[lane] = dtb; }
    const bf16_t* XBC = (const bf16_t*)(F.ws + WS_XBC); const float* cw = a.in[I_MCW] + (size_t)m * 3 * XBCW; const float* cbp = a.in[I_MCB] + (size_t)m * XBCW;
    const bf16_t* St = (const bf16_t*)(F.ws + WS_SST) + (size_t)(((cc * 2 + b) * 16 + hd) * 2) * 8192;
#pragma unroll
    for (int i = 0; i < 2; ++i) { const int idx = tid + i * 512, k = idx >> 4, n0 = (idx & 15) * 8; float v[8];
        conv8(XBC, cw, cbp, r0 + k, 1280 + grp * 128 + n0, v); *(LAS u32x4*)(Cs + k * 136 + n0) = pack8(v);
        conv8(XBC, cw, cbp, r0 + k, 1024 + grp * 128 + n0, v); *(LAS u32x4*)(Bs + k * 136 + n0) = pack8(v);
        *(LAS u32x4*)(Sf + k * 136 + n0) = *(const u32x4*)(St + (size_t)k * 128 + n0); *(LAS u32x4*)(Sb + k * 136 + n0) = *(const u32x4*)(St + 8192 + (size_t)k * 128 + n0); }
    { const int k = tid >> 3, p0 = (tid & 7) * 8; float v[8]; conv8(XBC, cw, cbp, r0 + k, hd * 64 + p0, v);
#pragma unroll
        for (int j = 0; j < 8; ++j) xt[(p0 + j) * 72 + k] = f2bf(v[j]); }
    __syncthreads();
    const int tq = w >> 1, q = 16 * tq + fr; const float cfq = cfa[q], sbq = sba[q];
#pragma unroll
    for (int t = 0; t < 2; ++t) { const int tk = (w & 1) * 2 + t; f32x4 acc = {0.f, 0.f, 0.f, 0.f}; acc = tile_mma<4>(Cs + 16 * tq * 136, 136, Bs + 16 * tk * 136, 136, acc, fr, fq);
#pragma unroll
        for (int i = 0; i < 4; ++i) { const int k = 16 * tk + 4 * fq + i; const float wd = (k <= q ? fexp(cfq - cfa[k]) * dfa[k] : 0.f) + (k >= q ? fexp(sbq - sba[k]) * dba[k] : 0.f); acc[i] *= wd; }
        st4l(W + q * 72 + 16 * tk + 4 * fq, acc); }
    __syncthreads();
    const float ef = fexp(cfq), eb = fexp(sbq), Dh = a.in[I_SD][m * 16 + hd]; const int row = r0 + q; float ssq = 0.f;
#pragma unroll
    for (int t = 0; t < 2; ++t) { const int tp = (w & 1) * 2 + t, p = 16 * tp + 4 * fq; const f32x4 z = {0.f, 0.f, 0.f, 0.f};
        const f32x4 aI = tile_mma<2>(W + 16 * tq * 72, 72, xt + 16 * tp * 72, 72, z, fr, fq);
        const f32x4 aF = tile_mma<4>(Cs + 16 * tq * 136, 136, Sf + 16 * tp * 136, 136, z, fr, fq);
        const f32x4 aB = tile_mma<4>(Cs + 16 * tq * 136, 136, Sb + 16 * tp * 136, 136, z, fr, fq);
        f32x4 y = aI + aF * ef + aB * eb;
        const u32x2 zz = *(const u32x2*)((const bf16_t*)(F.ws + WS_Z) + (size_t)row * 1024 + hd * 64 + p);
        const float zf[4] = {__uint_as_float(zz.x << 16), __uint_as_float(zz.x & 0xffff0000u), __uint_as_float(zz.y << 16), __uint_as_float(zz.y & 0xffff0000u)};
#pragma unroll
        for (int i = 0; i < 4; ++i) { y[i] = (y[i] + Dh * bf2f(xt[(p + i) * 72 + q])) * silu_f(zf[i]); ssq += y[i] * y[i]; }
        st4((bf16_t*)(F.ws + WS_MRG) + (size_t)row * D + 1024 + hd * 64 + p, y); }
    ssq += __shfl_xor(ssq, 16); ssq += __shfl_xor(ssq, 32);
    if (fq == 0) ((float*)(F.ws + WS_SSQ))[(size_t)row * 32 + hd * 2 + (w & 1)] = ssq;
    __syncthreads();
}
__device__ __forceinline__ void scanC_phase(const Frame& F, const Args& a, int m, int nC) {
    for (int u = F.vcu; u < nC * 16; u += F.G) retC_unit(F, a, m, u >> 4, (u >> 3) & 1, u & 7);
    for (int u = F.vcu; u < nC * 32; u += F.G) ssdC_unit(F, a, m, u >> 5, (u >> 4) & 1, u & 15);
}
__device__ __forceinline__ void ssdnorm_phase(const Frame& F, const Args& a, int m, int M) {
    const int gw = F.vcu * 8 + F.wave, NGW = F.G * 8, lane = F.lane;
    const float* ng = a.in[I_SNG] + (size_t)m * 1024 + lane * 16;
    for (int row = gw; row < M; row += NGW) {
        float s = ((const float*)(F.ws + WS_SSQ))[(size_t)row * 32 + (lane & 31)];
        s += __shfl_xor(s, 1); s += __shfl_xor(s, 2); s += __shfl_xor(s, 4); s += __shfl_xor(s, 8); s += __shfl_xor(s, 16);
        const float rstd = 1.0f / sqrtf(s * (1.0f / 1024.f) + EPS);
        bf16_t* p = (bf16_t*)(F.ws + WS_MRG) + (size_t)row * D + 1024 + lane * 16;
#pragma unroll
        for (int hf = 0; hf < 2; ++hf) { float f[8]; unpack8(*(const u32x4*)(p + 8 * hf), f);
#pragma unroll
            for (int j = 0; j < 8; ++j) f[j] *= rstd * ng[8 * hf + j];
            *(u32x4*)(p + 8 * hf) = pack8(f); }
    }
}

constexpr int N_PHASES = 55;
__global__ void __launch_bounds__(512, 2) fwd(Args args) {
    __shared__ __attribute__((aligned(16))) unsigned char lds_raw[LDS_BYTES];
    LAS unsigned char* const lds0 = (LAS unsigned char*)lds_raw;
    const int G = gridDim.x; int vcu; { const int bx = blockIdx.x; vcu = (G % 8 == 0) ? (bx % 8) * (G / 8) + bx / 8 : bx; }
    volatile LAS unsigned* MISC = (volatile LAS unsigned*)(lds0 + LDS_MISC);
    if (threadIdx.x < 64) MISC[threadIdx.x] = 0u;
    __syncthreads();
    const int lo = args.ph_lo, hi = args.ph_hi;
    XcdBarrier bar; bar.bar = (unsigned*)(args.ws + WS_CTL) + 4096; bar.x = 0; bar.st = MISC + 8;
    if (hi - lo > 1) bar = xcd_barrier_post((unsigned*)(args.ws + WS_CTL) + 4096, MISC + 8);
#define IN(k) (lo <= (k) && (k) < hi)
#define SEAM(k) do { if (IN(k) && IN((k) + 1)) xcd_barrier(bar); } while (0)
#define FRAME() const Frame F = mk_frame(args.ws, lds0, G, vcu); unsigned char* const ws = F.ws
    if (IN(0)) { FRAME(); (void)ws; prologue(F, args); }
    SEAM(0);
    if (IN(1)) { FRAME(); (void)ws; modreduce_phase(F, args); }
    SEAM(1);
#pragma nounroll
    for (int l = 0; l < 4; ++l) {
        const int pb = 2 + 13 * l, m = l >> 1; const bool even = (l & 1) == 0;
        const int Min = l <= 2 ? MTOT : MLAT, Mout = l < 2 ? MTOT : MLAT;
#pragma nounroll
        for (int half = 0; half < 2; ++half) {
            const int p0 = pb + 10 * half, Mf = half ? Mout : Min, fi = l * 2 + half;
            if (IN(p0)) { FRAME(); (void)ws; norm_phase(F, args, l, half ? 2 : 0, Mf); }
            SEAM(p0);
            if (IN(p0 + 1)) { FRAME(); pg8::Gemm g{(const bf16_t*)(ws + WS_H), (const bf16_t*)(ws + WS_WUP + fi * SZ_WUP), D}; pg8::StaticOrder S; S.init(Mf, 2 * DFF, G, (int)blockIdx.x);
                pg8::EpiUp E{(bf16_t*)(ws + WS_HID)}; pg8::gemm_phase<pg8::EpiUp, pg8::StaticOrder, true, true>(F.lds, F.tid, g, S, E); }
            SEAM(p0 + 1);
            if (IN(p0 + 2)) { FRAME(); pg8::Gemm g{(const bf16_t*)(ws + WS_HID), (const bf16_t*)(ws + WS_WDN + fi * SZ_WDN), DFF}; pg8::StaticOrder S; S.init(Mf, D, G, (int)blockIdx.x);
                pg8::EpiRes E{(float*)(ws + WS_X), (const float*)(ws + WS_MOD) + (size_t)(l * 27 + (half ? 8 : 2)) * D, 0.5f}; pg8::gemm_phase<pg8::EpiRes, pg8::StaticOrder, true, true>(F.lds, F.tid, g, S, E); }
            SEAM(p0 + 2);
            if (half == 0) {
                if (IN(pb + 3)) { FRAME(); (void)ws; norm_phase(F, args, l, 1, Min); }
                SEAM(pb + 3);
                if (even) {
                    if (IN(pb + 4)) { FRAME(); pg8::Gemm g{(const bf16_t*)(ws + WS_H), (const bf16_t*)(ws + WS_WMI + m * SZ_WMI), D}; pg8::StaticOrder S; S.init(Min, 6912, G, (int)blockIdx.x);
                        pg8::EpiInEven E{(bf16_t*)(ws + WS_Q), (float*)(ws + WS_DT),
                            (const float*)(ws + WS_ROPE), (const float*)(ws + WS_ROPE) + 4352 * 64, args.in[I_SDTB] + m * 32};
                        pg8::gemm_phase<pg8::EpiInEven, pg8::StaticOrder, true, true>(F.lds, F.tid, g, S, E); }
                    SEAM(pb + 4);
                    if (IN(pb + 5)) { FRAME(); (void)ws; scanA_phase(F, args, m); }
                    SEAM(pb + 5);
                    if (IN(pb + 6)) { FRAME(); (void)ws; scanB_phase(F, args, m); }
                    SEAM(pb + 6);
                    if (IN(pb + 7)) { FRAME(); (void)ws; scanC_phase(F, args, m, Mout == MTOT ? 68 : 64); }
                    SEAM(pb + 7);
                    if (IN(pb + 8)) { FRAME(); (void)ws; ssdnorm_phase(F, args, m, Mout); }
                    SEAM(pb + 8);
                } else {
                    if (IN(pb + 4)) { FRAME(); pg8::Gemm g{(const bf16_t*)(ws + WS_H), (const bf16_t*)(ws + WS_WSI + m * SZ_WSI), D}; pg8::StaticOrder S; S.init(Mout, 3 * D, G, (int)blockIdx.x);
                        pg8::EpiInOdd E{(bf16_t*)(ws + WS_BG), (bf16_t*)(ws + WS_T)}; pg8::gemm_phase<pg8::EpiInOdd, pg8::StaticOrder, true, true>(F.lds, F.tid, g, S, E); }
                    SEAM(pb + 4);
                    if (IN(pb + 5)) { FRAME(); (void)ws; scconv_phase(F, args, m, Mout); }
                    if (IN(pb + 5) && IN(pb + 9)) xcd_barrier(bar);
                }
                if (IN(pb + 9)) { FRAME(); pg8::Gemm g{(const bf16_t*)(ws + WS_MRG), (const bf16_t*)(ws + (even ? WS_WMO : WS_WSO) + m * SZ_WSQ), D}; pg8::StaticOrder S; S.init(Mout, D, G, (int)blockIdx.x);
                    pg8::EpiRes E{(float*)(ws + WS_X), (const float*)(ws + WS_MOD) + (size_t)(l * 27 + 5) * D, 1.0f}; pg8::gemm_phase<pg8::EpiRes, pg8::StaticOrder, true, true>(F.lds, F.tid, g, S, E); }
                SEAM(pb + 9);
            }
        }
    }
    if (IN(54)) { FRAME(); (void)ws;
#if DBG_DUMP == 1
        dbg_dump(F, args, WS_Q, 5 * SZ_P1 + (size_t)MTOT * XBCW * 2);
#elif DBG_DUMP == 2
        dbg_dump(F, args, WS_DT, (size_t)MTOT * 32 * 4);
#elif DBG_DUMP == 3
        dbg_dump(F, args, WS_RST, 2 * SZ_ST);
#elif DBG_DUMP == 6
        dbg_dump(F, args, WS_RST, SZ_ST);
#elif DBG_DUMP == 7
        dbg_dump(F, args, WS_SST, SZ_ST);
#elif DBG_DUMP == 4
        dbg_dump(F, args, WS_MRG, (size_t)MTOT * D * 2);
#elif DBG_DUMP == 5
        dbg_dump(F, args, WS_SSQ, (size_t)MTOT * 32 * 4);
#else
        final_phase(F, args);
#endif
    }
#undef IN
#undef SEAM
#undef FRAME
}

extern "C" void kernel_launch(void* const* d_in, const int* in_sizes, int n_in, void* d_out, int out_size, void* d_ws, size_t ws_size, hipStream_t stream) {
    static int grid = 0;
    if (grid == 0) {
        if (n_in != 23 || out_size != MLAT * D || ws_size < WS_END) { fprintf(stderr, "kernel_launch: unexpected shapes (n_in %d, out %d, ws %zu < %zu)\n", n_in, out_size, ws_size, (size_t)WS_END); grid = -1; return; }
        int dev = 0, cus = 0, per_cu = 0;
        if (hipGetDevice(&dev) != hipSuccess || hipDeviceGetAttribute(&cus, hipDeviceAttributeMultiprocessorCount, dev) != hipSuccess) { grid = -1; return; }
        if (hipOccupancyMaxActiveBlocksPerMultiprocessor(&per_cu, (const void*)fwd, 512, 0) != hipSuccess || per_cu < 1) fprintf(stderr, "kernel_launch: occupancy query reports %d\n", per_cu);
        (void)hipGetLastError();
        grid = cus;
    }
    if (grid < 0) return;
    (void)hipMemsetAsync((char*)d_ws, 0, ZERO_BYTES, stream);
    Args a{};
    for (int i = 0; i < 23; ++i) a.in[i] = (const float*)d_in[i];
    a.out = (float*)d_out; a.ws = (unsigned char*)d_ws;
#if MK_PER_PHASE
    for (int p = 0; p < N_PHASES; ++p) {
        const int l = (p - 2) / 13, s = (p - 2) % 13;
        if (p >= 2 && p <= 53 && (l & 1) && (s >= 6 && s <= 8)) continue;
        if (p > DBG_MAXPH && p != N_PHASES - 1) continue;
        a.ph_lo = p; a.ph_hi = p + 1;
        hipLaunchKernelGGL(fwd, dim3(grid), dim3(512), 0, stream, a);
    }
#else
    a.ph_lo = 0; a.ph_hi = N_PHASES;
    hipLaunchKernelGGL(fwd, dim3(grid), dim3(512), 0, stream, a);
#endif
}
```
